# Optimizing an MI355X kernel written in HIP

```python
import jax, jax.numpy as jnp
from jax import lax
import numpy as np

D_MODEL = 2048
BATCH = 8
SEQ = 2048
DEPTH = 2

A_CHUNK = 128
A_HALF = D_MODEL
A_GROUPS = A_HALF // 128
A_GROUP_DIM = A_HALF // A_GROUPS
HEAD_DIM = 64
N_Q_HEADS = D_MODEL // HEAD_DIM
N_KV_HEADS = N_Q_HEADS // 8
Q_PER_KV = N_Q_HEADS // N_KV_HEADS
QKV_DIM = (N_Q_HEADS + 2 * N_KV_HEADS) * HEAD_DIM
WINDOW = 128
ATTN_BLOCK = 128
N_EXPERTS = 64
TOP_K = 8
N_GROUPS = 8
TOPK_GROUPS = 4
EXPERT_FF = D_MODEL // 4
SHARED_FF = EXPERT_FF
ROUTED_SCALE = 2.5
MOE_BLOCK = 128
DN_ALPHA = (2 * DEPTH) ** 0.25
DN_BETA = (8 * DEPTH) ** -0.25
LN_EPS = 1e-5
N_A_LAYERS = (DEPTH + 1) // 2
N_B_LAYERS = DEPTH // 2

kernel_name = 'hybrid_gmlp_swa_sinks_moe_deepnorm'


def layer_norm(x, g, b):
    xf = x.astype(jnp.float32)
    mu = jnp.mean(xf, axis=-1, keepdims=True)
    var = jnp.mean(jnp.square(xf - mu), axis=-1, keepdims=True)
    y = (xf - mu) * lax.rsqrt(var + LN_EPS)
    return (y * g.astype(jnp.float32) + b.astype(jnp.float32)).astype(x.dtype)


def chunked_gmlp(x, w_in, b_in, ln_g, ln_b, w_s, b_s, w_out):
    bsz, s_len, _ = x.shape
    z = jax.nn.gelu(x @ w_in + b_in, approximate=False)
    u, v = z[..., :A_HALF], z[..., A_HALF:]
    v = layer_norm(v, ln_g, ln_b)
    nc = s_len // A_CHUNK
    v = v.reshape(bsz, nc, A_CHUNK, A_GROUPS, A_GROUP_DIM)
    causal = jnp.tril(jnp.ones((A_CHUNK, A_CHUNK), dtype=bool))
    w_mix = jnp.where(causal[None], w_s, 0.0).astype(v.dtype)
    mixed = jnp.einsum('gts,bnsgc->bntgc', w_mix, v) + jnp.transpose(b_s)[None, None, :, :, None]
    gated = u * mixed.reshape(bsz, s_len, A_HALF)
    return gated @ w_out


def swa_sinks_attention(x, w_qkv, b_qkv, sinks, w_o, b_o):
    bsz, s_len, _ = x.shape
    nb = s_len // ATTN_BLOCK
    qkv = x @ w_qkv + b_qkv
    q_end = N_Q_HEADS * HEAD_DIM
    k_end = q_end + N_KV_HEADS * HEAD_DIM
    q = qkv[..., :q_end].reshape(bsz, nb, ATTN_BLOCK, N_KV_HEADS, Q_PER_KV, HEAD_DIM)
    k = qkv[..., q_end:k_end].reshape(bsz, nb, ATTN_BLOCK, N_KV_HEADS, HEAD_DIM)
    v = qkv[..., k_end:].reshape(bsz, nb, ATTN_BLOCK, N_KV_HEADS, HEAD_DIM)

    def with_prev(t):
        prev = jnp.concatenate([jnp.zeros_like(t[:, :1]), t[:, :-1]], axis=1)
        return jnp.concatenate([prev, t], axis=2)

    kk, vv = with_prev(k), with_prev(v)
    scores = jnp.einsum('bnqkgd,bnskd->bnkgqs', q, kk).astype(jnp.float32) * (HEAD_DIM ** -0.5)

    qi = jnp.arange(ATTN_BLOCK)[:, None]
    kj = jnp.arange(2 * ATTN_BLOCK)[None, :]
    dist = qi + ATTN_BLOCK - kj
    key_abs = jnp.arange(nb)[:, None, None] * ATTN_BLOCK + kj[None] - ATTN_BLOCK
    valid = (dist >= 0)[None] & (dist < WINDOW)[None] & (key_abs >= 0)

    head = jnp.arange(1, N_Q_HEADS + 1, dtype=jnp.float32)
    slopes = jnp.exp2(-8.0 * head / N_Q_HEADS).reshape(N_KV_HEADS, Q_PER_KV)
    alibi = -slopes[:, :, None, None] * dist.astype(jnp.float32)[None, None]
    scores = jnp.where(valid[None, :, None, None], scores + alibi[None, None], -jnp.inf)

    sink = sinks.astype(jnp.float32).reshape(N_KV_HEADS, Q_PER_KV)[None, None, :, :, None]
    m = jnp.maximum(jnp.max(scores, axis=-1), sink)
    e = jnp.exp(scores - m[..., None])
    denom = jnp.sum(e, axis=-1) + jnp.exp(sink - m)
    p = (e / denom[..., None]).astype(vv.dtype)
    o = jnp.einsum('bnkgqs,bnskd->bnqkgd', p, vv).reshape(bsz, s_len, N_Q_HEADS * HEAD_DIM)
    return o @ w_o + b_o


def moe_ffn(x, w_router, router_bias, w_gate, w_up, w_down, ws_gate, ws_up, ws_down):
    bsz, s_len, d = x.shape
    n_tok = bsz * s_len
    x2 = x.reshape(n_tok, d)
    scores = jax.nn.sigmoid(x2.astype(jnp.float32) @ w_router.astype(jnp.float32))
    sel = scores + router_bias.astype(jnp.float32)
    grp = sel.reshape(n_tok, N_GROUPS, N_EXPERTS // N_GROUPS)
    grp_score = jnp.sum(lax.top_k(grp, 2)[0], axis=-1)
    gidx = lax.top_k(grp_score, TOPK_GROUPS)[1]
    gmask = jnp.any(gidx[..., None] == jnp.arange(N_GROUPS), axis=-2)
    emask = jnp.repeat(gmask, N_EXPERTS // N_GROUPS, axis=-1)
    idx = lax.top_k(jnp.where(emask, sel, -jnp.inf), TOP_K)[1]
    wts = jnp.take_along_axis(scores, idx, axis=-1)
    wts = wts / (jnp.sum(wts, axis=-1, keepdims=True) + 1e-20) * ROUTED_SCALE

    n_assign = n_tok * TOP_K
    flat_e = idx.reshape(-1)
    flat_w = wts.reshape(-1)
    order = jnp.argsort(flat_e)
    sorted_e = flat_e[order]
    counts = jnp.bincount(flat_e, length=N_EXPERTS)
    padded = (counts + MOE_BLOCK - 1) // MOE_BLOCK * MOE_BLOCK
    pad_end = jnp.cumsum(padded)
    pad_start = pad_end - padded
    start = jnp.cumsum(counts) - counts
    dest = pad_start[sorted_e] + jnp.arange(n_assign) - start[sorted_e]
    n_blocks = n_assign // MOE_BLOCK + N_EXPERTS
    n_slots = n_blocks * MOE_BLOCK
    slot_tok = jnp.zeros((n_slots,), jnp.int32).at[dest].set((order // TOP_K).astype(jnp.int32))
    slot_w = jnp.zeros((n_slots,), jnp.float32).at[dest].set(flat_w[order])
    block_e = jnp.minimum(jnp.searchsorted(pad_end, jnp.arange(n_blocks) * MOE_BLOCK, side='right'),
                          N_EXPERTS - 1)

    def expert_block(args):
        tok, e, gw = args
        xb = x2[tok]
        h = jax.nn.silu(xb @ w_gate[e]) * (xb @ w_up[e])
        return (h @ w_down[e]) * gw.astype(xb.dtype)[:, None]

    y = lax.map(expert_block, (slot_tok.reshape(n_blocks, MOE_BLOCK), block_e,
                               slot_w.reshape(n_blocks, MOE_BLOCK)))
    routed = jax.ops.segment_sum(y.reshape(n_slots, d), slot_tok, num_segments=n_tok)
    shared = (jax.nn.silu(x2 @ ws_gate) * (x2 @ ws_up)) @ ws_down
    return (routed + shared).reshape(bsz, s_len, d)


def setup_inputs(seed: int = 0) -> dict:
    key = jax.random.key(seed)
    ks = jax.random.split(key, 24)
    f32 = jnp.float32
    nrm = lambda k, shape, scale: jax.random.normal(k, shape, f32) * scale
    d = D_MODEL
    x = jax.random.normal(ks[0], (BATCH, SEQ, d), f32)
    a_w_in = nrm(ks[1], (N_A_LAYERS, d, 2 * A_HALF), d ** -0.5)
    a_b_in = nrm(ks[2], (N_A_LAYERS, 2 * A_HALF), 0.01)
    a_ln_g = 1.0 + nrm(ks[3], (N_A_LAYERS, A_HALF), 0.01)
    a_ln_b = nrm(ks[4], (N_A_LAYERS, A_HALF), 0.01)
    a_w_s = nrm(ks[5], (N_A_LAYERS, A_GROUPS, A_CHUNK, A_CHUNK), A_CHUNK ** -0.5)
    a_b_s = 1.0 + nrm(ks[6], (N_A_LAYERS, A_GROUPS, A_CHUNK), 0.01)
    a_w_out = nrm(ks[7], (N_A_LAYERS, A_HALF, d), A_HALF ** -0.5 * DN_BETA)
    v_start = (N_Q_HEADS + N_KV_HEADS) * HEAD_DIM
    b_w_qkv = nrm(ks[8], (N_B_LAYERS, d, QKV_DIM), d ** -0.5)
    b_w_qkv = b_w_qkv.at[:, :, v_start:].multiply(DN_BETA)
    b_b_qkv = nrm(ks[9], (N_B_LAYERS, QKV_DIM), 0.01)
    b_sinks = nrm(ks[10], (N_B_LAYERS, N_Q_HEADS), 0.5)
    b_w_o = nrm(ks[11], (N_B_LAYERS, N_Q_HEADS * HEAD_DIM, d), (N_Q_HEADS * HEAD_DIM) ** -0.5 * DN_BETA)
    b_b_o = nrm(ks[12], (N_B_LAYERS, d), 0.01)
    moe_w_router = nrm(ks[13], (DEPTH, d, N_EXPERTS), d ** -0.5)
    moe_router_bias = nrm(ks[14], (DEPTH, N_EXPERTS), 0.01)
    moe_w_gate = nrm(ks[15], (DEPTH, N_EXPERTS, d, EXPERT_FF), d ** -0.5)
    moe_w_up = nrm(ks[16], (DEPTH, N_EXPERTS, d, EXPERT_FF), d ** -0.5)
    moe_w_down = nrm(ks[17], (DEPTH, N_EXPERTS, EXPERT_FF, d), EXPERT_FF ** -0.5 * DN_BETA)
    moe_ws_gate = nrm(ks[18], (DEPTH, d, SHARED_FF), d ** -0.5)
    moe_ws_up = nrm(ks[19], (DEPTH, d, SHARED_FF), d ** -0.5)
    moe_ws_down = nrm(ks[20], (DEPTH, SHARED_FF, d), SHARED_FF ** -0.5 * DN_BETA)
    norm_g = 1.0 + nrm(ks[21], (DEPTH, 2, d), 0.01)
    norm_b = nrm(ks[22], (DEPTH, 2, d), 0.01)
    return {'x': x,
            'a_w_in': a_w_in, 'a_b_in': a_b_in, 'a_ln_g': a_ln_g, 'a_ln_b': a_ln_b,
            'a_w_s': a_w_s, 'a_b_s': a_b_s, 'a_w_out': a_w_out,
            'b_w_qkv': b_w_qkv, 'b_b_qkv': b_b_qkv, 'b_sinks': b_sinks, 'b_w_o': b_w_o, 'b_b_o': b_b_o,
            'moe_w_router': moe_w_router, 'moe_router_bias': moe_router_bias,
            'moe_w_gate': moe_w_gate, 'moe_w_up': moe_w_up, 'moe_w_down': moe_w_down,
            'moe_ws_gate': moe_ws_gate, 'moe_ws_up': moe_ws_up, 'moe_ws_down': moe_ws_down,
            'norm_g': norm_g, 'norm_b': norm_b}


def reference(x, a_w_in, a_b_in, a_ln_g, a_ln_b, a_w_s, a_b_s, a_w_out,
              b_w_qkv, b_b_qkv, b_sinks, b_w_o, b_b_o,
              moe_w_router, moe_router_bias, moe_w_gate, moe_w_up, moe_w_down,
              moe_ws_gate, moe_ws_up, moe_ws_down, norm_g, norm_b):
    for i in range(DEPTH):
        j = i // 2
        if i % 2 == 0:
            mix = chunked_gmlp(x, a_w_in[j], a_b_in[j], a_ln_g[j], a_ln_b[j], a_w_s[j], a_b_s[j], a_w_out[j])
        else:
            mix = swa_sinks_attention(x, b_w_qkv[j], b_b_qkv[j], b_sinks[j], b_w_o[j], b_b_o[j])
        x = layer_norm(DN_ALPHA * x + mix, norm_g[i, 0], norm_b[i, 0])
        ffn = moe_ffn(x, moe_w_router[i], moe_router_bias[i], moe_w_gate[i], moe_w_up[i], moe_w_down[i],
                      moe_ws_gate[i], moe_ws_up[i], moe_ws_down[i])
        x = layer_norm(DN_ALPHA * x + ffn, norm_g[i, 1], norm_b[i, 1])
    return x
```

```cpp
#include <hip/hip_runtime.h>
#include <cstdio>
#include <cstdint>

#ifndef PH_MASK
#define PH_MASK 0x7ff
#endif
#define EN(k) (((PH_MASK) >> (k)) & 1)
#ifndef MK_N_LAUNCHES
#define MK_N_LAUNCHES 15
#endif

namespace pg8 {
#define PG8_LAS __attribute__((address_space(3)))
typedef unsigned short bf16_t;
typedef short bf16x8 __attribute__((ext_vector_type(8)));
typedef float f32x4 __attribute__((ext_vector_type(4)));
typedef float f32x2 __attribute__((ext_vector_type(2)));
typedef unsigned u32x4 __attribute__((ext_vector_type(4)));
typedef unsigned u32x2 __attribute__((ext_vector_type(2)));
constexpr int BM = 256, BK = 64, HALF = 128, HTB = HALF * BK * 2, STAGE_BYTES = 8 * HTB, NXCD = 8, WGM = 8;

__host__ __device__ __forceinline__ int lds_byte(int r, int c) { const int st = (r >> 4) * 2 + (c >> 5), rr = r & 15, cc = c & 31, ob = rr * 64 + cc * 2; return st * 1024 + (ob ^ (((ob >> 9) & 1) << 5)); }
__host__ __device__ __forceinline__ void stage_rc(int b, int& R, int& C) { const int st = b / 1024, sb = b % 1024, swz = sb ^ (((sb >> 9) & 1) << 5); R = (st >> 1) * 16 + swz / 64; C = (st & 1) * 32 + (swz % 64) / 2; }
__host__ __device__ __forceinline__ int perm32(int rho) { const int n = rho >> 4, i = rho & 15; return 8 * (i >> 2) + 4 * n + (i & 3); }

struct Unit { int pm, pn, pb, ord; };
struct Gemm { const bf16_t* A; const bf16_t* Bt; int K; };

struct StaticOrder {
    static constexpr bool GATHER = false;
    int nM, nN, nwg, G, c;
    __device__ __forceinline__ void init(int nM_, int nN_, int G_, int c_) { nM = nM_; nN = nN_; nwg = nM * nN; G = G_; c = c_; }
    __device__ __forceinline__ bool map(int i, int& pm, int& pn) const {
        const long L = (long)i * G + c; if (L >= nwg) return false;
        int wgid = (int)L; { const int q = nwg / NXCD, r = nwg % NXCD, xcd = wgid % NXCD, off = wgid / NXCD; wgid = (xcd < r ? xcd * (q + 1) : r * (q + 1) + (xcd - r) * q) + off; }
        const int nig = WGM * nN, gid = wgid / nig, fm = gid * WGM, gsz = (nM - fm) < WGM ? (nM - fm) : WGM;
        pm = fm + ((wgid % nig) % gsz); pn = (wgid % nig) / gsz; return true;
    }
    __device__ __forceinline__ bool next(int i, Unit& u) const { if (!map(i, u.pm, u.pn)) return false; u.pb = u.pn; u.ord = i; return true; }
    __device__ __forceinline__ unsigned rowoff(int, int) const { return 0u; }
};

__device__ __forceinline__ unsigned cvt_pk_bf16(float lo, float hi) { unsigned r; asm volatile("v_cvt_pk_bf16_f32 %0, %1, %2" : "=v"(r) : "v"(lo), "v"(hi)); return r; }
__device__ __forceinline__ f32x2 gelu_pk(f32x2 v) {
    const f32x2 av = __builtin_elementwise_abs(v), d = av * 0.2316418882f + 1.0f;
    f32x2 t; t.x = __builtin_amdgcn_rcpf(d.x); t.y = __builtin_amdgcn_rcpf(d.y);
    f32x2 q = t * 0.5307027145f + (-0.7265760135f); q = q * t + 0.7107068705f; q = q * t + (-0.142248368f); q = q * t + 0.127414796f; q = q * t;
    const f32x2 s = (v * v) * (-0.72134752044f);
    f32x2 e; e.x = __builtin_amdgcn_exp2f(s.x); e.y = __builtin_amdgcn_exp2f(s.y);
    const f32x2 m = v * (q * e), r = v - m;
    f32x2 o; o.x = v.x < 0.f ? m.x : r.x; o.y = v.y < 0.f ? m.y : r.y; return o;
}
template <int CTRL> __device__ __forceinline__ float dppf(float v) { return __builtin_bit_cast(float, __builtin_amdgcn_update_dpp(0, __builtin_bit_cast(int, v), CTRL, 0xf, 0xf, false)); }
__device__ __forceinline__ float row16_sum(float v) { v += dppf<0xB1>(v); v += dppf<0x4E>(v); v += dppf<0x141>(v); v += dppf<0x128>(v); return v; }

template <int ACT> struct EpiBf16 {
    static constexpr bool PERM = true;
    bf16_t* O; int ldc; const float* bias; int nscale; float scale0;
    __device__ __forceinline__ void operator()(const f32x4 (&acc)[2][2][4][2], const Unit& u, int wr, int wc, int fr, int fq, PG8_LAS unsigned char*) const {
        const int row0 = u.pm * BM + wr * 64 + fr; const int col0 = u.pn * BM + wc * 32 + 8 * fq;
        const float sc = (u.pn < nscale) ? scale0 : 1.f;
        f32x4 bv[2][2];
#pragma unroll
        for (int bj = 0; bj < 2; ++bj)
#pragma unroll
            for (int n = 0; n < 2; ++n) bv[bj][n] = bias ? *(const f32x4*)(bias + col0 + bj * HALF + 4 * n) : (f32x4){0.f, 0.f, 0.f, 0.f};
#pragma unroll
        for (int ai = 0; ai < 2; ++ai)
#pragma unroll
            for (int m = 0; m < 4; ++m) { bf16_t* rowp = O + (size_t)(row0 + ai * HALF + m * 16) * ldc + col0;
#pragma unroll
                for (int bj = 0; bj < 2; ++bj) { f32x4 v0 = acc[ai][bj][m][0] + bv[bj][0], v1 = acc[ai][bj][m][1] + bv[bj][1];
                    if (ACT == 1) { f32x2 a = gelu_pk((f32x2){v0[0], v0[1]}), b = gelu_pk((f32x2){v0[2], v0[3]}), c = gelu_pk((f32x2){v1[0], v1[1]}), d = gelu_pk((f32x2){v1[2], v1[3]});
                        v0 = (f32x4){a.x, a.y, b.x, b.y}; v1 = (f32x4){c.x, c.y, d.x, d.y}; }
                    v0 = v0 * sc; v1 = v1 * sc; u32x4 w; w.x = cvt_pk_bf16(v0[0], v0[1]); w.y = cvt_pk_bf16(v0[2], v0[3]); w.z = cvt_pk_bf16(v1[0], v1[1]); w.w = cvt_pk_bf16(v1[2], v1[3]);
                    *(u32x4*)(rowp + bj * HALF) = w; } }
    }
};
template <bool GELU, bool STATS> struct EpiRowBias {
    static constexpr bool PERM = true;
    bf16_t* O; int ldc; const float* rbias; float* stat; int T;
    __device__ __forceinline__ void operator()(const f32x4 (&acc)[2][2][4][2], const Unit& u, int wr, int wc, int fr, int fq, PG8_LAS unsigned char*) const {
        const int row0 = u.pm * BM + wr * 64 + fr; const int col0 = u.pn * BM + wc * 32 + 8 * fq;
#pragma unroll
        for (int bj = 0; bj < 2; ++bj) {
            f32x4 s1[2], s2[2];
#pragma unroll
            for (int n = 0; n < 2; ++n) { s1[n] = (f32x4){0.f, 0.f, 0.f, 0.f}; s2[n] = (f32x4){0.f, 0.f, 0.f, 0.f}; }
#pragma unroll
            for (int ai = 0; ai < 2; ++ai)
#pragma unroll
                for (int m = 0; m < 4; ++m) { const int row = row0 + ai * HALF + m * 16; const float rb = rbias[row];
                    f32x4 v0 = acc[ai][bj][m][0] + rb, v1 = acc[ai][bj][m][1] + rb;
                    if (GELU) { f32x2 a = gelu_pk((f32x2){v0[0], v0[1]}), b = gelu_pk((f32x2){v0[2], v0[3]}), c = gelu_pk((f32x2){v1[0], v1[1]}), d = gelu_pk((f32x2){v1[2], v1[3]});
                        v0 = (f32x4){a.x, a.y, b.x, b.y}; v1 = (f32x4){c.x, c.y, d.x, d.y}; }
                    if (STATS) { s1[0] += v0; s1[1] += v1; s2[0] += v0 * v0; s2[1] += v1 * v1; }
                    u32x4 w; w.x = cvt_pk_bf16(v0[0], v0[1]); w.y = cvt_pk_bf16(v0[2], v0[3]); w.z = cvt_pk_bf16(v1[0], v1[1]); w.w = cvt_pk_bf16(v1[2], v1[3]);
                    *(u32x4*)(O + (size_t)row * ldc + col0 + bj * HALF) = w; }
            if (STATS) {
#pragma unroll
                for (int n = 0; n < 2; ++n)
#pragma unroll
                    for (int j = 0; j < 4; ++j) { s1[n][j] = row16_sum(s1[n][j]); s2[n][j] = row16_sum(s2[n][j]); }
                if (fr == 0) { const int P = u.pm * 2 + wr; float* sp = stat + ((size_t)P * T + col0 + bj * HALF) * 2;
#pragma unroll
                    for (int n = 0; n < 2; ++n) { *(f32x4*)(sp + 8 * n) = (f32x4){s1[n][0], s2[n][0], s1[n][1], s2[n][1]}; *(f32x4*)(sp + 8 * n + 4) = (f32x4){s1[n][2], s2[n][2], s1[n][3], s2[n][3]}; } }
            }
        }
    }
};
struct EpiResF32 {
    static constexpr bool PERM = false;
    const float* res; float* out; int ldc; const float* bias; float alpha;
    __device__ __forceinline__ void operator()(const f32x4 (&acc)[2][2][4][2], const Unit& u, int wr, int wc, int fr, int fq, PG8_LAS unsigned char*) const {
        const int row0 = u.pm * BM + wr * 64 + fr, col0 = u.pn * BM + wc * 32 + 4 * fq;
        f32x4 bv[2][2];
#pragma unroll
        for (int bj = 0; bj < 2; ++bj)
#pragma unroll
            for (int n = 0; n < 2; ++n) bv[bj][n] = bias ? *(const f32x4*)(bias + col0 + bj * HALF + n * 16) : (f32x4){0.f, 0.f, 0.f, 0.f};
#pragma unroll
        for (int ai = 0; ai < 2; ++ai)
#pragma unroll
            for (int m = 0; m < 4; ++m) { const size_t off = (size_t)(row0 + ai * HALF + m * 16) * ldc + col0;
                f32x4 rv[2][2];
#pragma unroll
                for (int bj = 0; bj < 2; ++bj)
#pragma unroll
                    for (int n = 0; n < 2; ++n) rv[bj][n] = *(const f32x4*)(res + off + bj * HALF + n * 16);
#pragma unroll
                for (int bj = 0; bj < 2; ++bj)
#pragma unroll
                    for (int n = 0; n < 2; ++n) *(f32x4*)(out + off + bj * HALF + n * 16) = rv[bj][n] * alpha + acc[ai][bj][m][n] + bv[bj][n];
                if (m & 1) asm volatile("" ::: "memory"); }
    }
};
struct EpiSwiGLU {
    static constexpr bool PERM = true;
    bf16_t* H; int ldc; int roww_off;
    __device__ __forceinline__ void operator()(const f32x4 (&acc)[2][2][4][2], const Unit& u, int wr, int wc, int fr, int fq, PG8_LAS unsigned char* ldsbase) const {
        const int row0 = u.pm * BM + wr * 64 + fr; const int col0 = u.pn * HALF + wc * 32 + 8 * fq;
        const PG8_LAS float* rw = (const PG8_LAS float*)(ldsbase + roww_off) + u.ord * 256 + wr * 64 + fr;
#pragma unroll
        for (int ai = 0; ai < 2; ++ai)
#pragma unroll
            for (int m = 0; m < 4; ++m) { const float w = rw[ai * HALF + m * 16]; bf16_t* rowp = H + (size_t)(row0 + ai * HALF + m * 16) * ldc + col0;
                f32x4 o[2];
#pragma unroll
                for (int n = 0; n < 2; ++n) { const f32x4 g = acc[ai][0][m][n], up = acc[ai][1][m][n];
#pragma unroll
                    for (int j = 0; j < 4; ++j) { const float sg = g[j] * __builtin_amdgcn_rcpf(1.0f + __builtin_amdgcn_exp2f(-1.44269504089f * g[j])); o[n][j] = sg * up[j] * w; } }
                u32x4 pk; pk.x = cvt_pk_bf16(o[0][0], o[0][1]); pk.y = cvt_pk_bf16(o[0][2], o[0][3]); pk.z = cvt_pk_bf16(o[1][0], o[1][1]); pk.w = cvt_pk_bf16(o[1][2], o[1][3]);
                *(u32x4*)rowp = pk; }
    }
};

template <class Epi, class Sched, bool ALIGN_EPI = true>
__device__ __forceinline__ void gemm_phase(PG8_LAS unsigned char* lds, PG8_LAS unsigned char* ldsbase, const Gemm g, const Sched& S, const Epi& E) {
    constexpr bool GATHER = Sched::GATHER;
    const int tid = threadIdx.x, wid = __builtin_amdgcn_readfirstlane(tid >> 6), lane = tid & 63, wr = wid >> 2, wc = wid & 3, fr = lane & 15, fq = lane >> 4;
    const int K = g.K, nt = K / BK;
    unsigned voffA[2], voffB[2];
#pragma unroll
    for (int i = 0; i < 2; ++i) { int R, C; stage_rc(tid * 16 + i * 8192, R, C); const int Rb = Epi::PERM ? ((R & ~31) + perm32(R & 31)) : R;
        voffA[i] = (unsigned)(R * K + C) * 2u; voffB[i] = (unsigned)(Rb * K + C) * 2u; }
    unsigned gA[2][2];
#define PG8_LOAD_GA(ordv) do { _Pragma("unroll") for (int _h = 0; _h < 2; ++_h) _Pragma("unroll") for (int _i = 0; _i < 2; ++_i) { int _R, _C; stage_rc(tid * 16 + _i * 8192, _R, _C); \
        gA[_h][_i] = S.rowoff((ordv), _h * HALF + _R) + (unsigned)_C * 2u; } } while (0)
    const size_t kstep = (size_t)(BK * 2);
    const size_t hstep = (size_t)HALF * K * 2;
    const size_t tstep = 2 * hstep;
    const unsigned ldsw = (unsigned)wid * 1024u;
    const int aoff = lds_byte(wr * 64 + fr, fq * 8), boff = lds_byte(wc * 32 + fr, fq * 8);
#define PG8_SA(b, h) (((b) * 2 + (h)) * HTB)
#define PG8_SB(b, h) ((4 + (b) * 2 + (h)) * HTB)
#define PG8_STAGE(bufoff, gbase, voff) do { _Pragma("unroll") for (int _i = 0; _i < 2; ++_i) \
        __builtin_amdgcn_global_load_lds((const unsigned*)((const char*)(gbase) + (voff)[_i]), (PG8_LAS unsigned*)(lds + (bufoff) + ldsw + _i * 8192), 16, 0, 0); } while (0)
#define PG8_STAGE_A(b, h, kptr) do { if constexpr (GATHER) { PG8_STAGE(PG8_SA(b, h), kptr, gA[h]); } else { PG8_STAGE(PG8_SA(b, h), (kptr) + (h) * hstep, voffA); } } while (0)
#define PG8_LDA(dst, b, h) do { _Pragma("unroll") for (int m = 0; m < 4; ++m) _Pragma("unroll") for (int k = 0; k < 2; ++k) dst[m][k] = *(const PG8_LAS bf16x8*)(lds + PG8_SA(b, h) + aoff + m * 2048 + k * 1024); } while (0)
#define PG8_LDB(dst, b, h) do { _Pragma("unroll") for (int n = 0; n < 2; ++n) _Pragma("unroll") for (int k = 0; k < 2; ++k) dst[n][k] = *(const PG8_LAS bf16x8*)(lds + PG8_SB(b, h) + boff + n * 2048 + k * 1024); } while (0)
#define PG8_MMA(ai, bj, At, Bt) do { __builtin_amdgcn_s_setprio(1); _Pragma("unroll") for (int m = 0; m < 4; ++m) _Pragma("unroll") for (int n = 0; n < 2; ++n) _Pragma("unroll") for (int k = 0; k < 2; ++k) \
        acc[ai][bj][m][n] = __builtin_amdgcn_mfma_f32_16x16x32_bf16(Bt[n][k], At[m][k], acc[ai][bj][m][n], 0, 0, 0); __builtin_amdgcn_s_setprio(0); } while (0)
#define PG8_WAIT_V(n) asm volatile("s_waitcnt vmcnt(" #n ")" ::: "memory")
#define PG8_WAIT_L(n) asm volatile("s_waitcnt lgkmcnt(" #n ")" ::: "memory")
#define PG8_BAR __builtin_amdgcn_s_barrier()
#define PG8_SCHED __builtin_amdgcn_sched_barrier(0)
    Unit cur, nxt; int ui = 0;
    if (!S.next(0, cur)) return;
    f32x4 acc[2][2][4][2];
#pragma unroll
    for (int a = 0; a < 2; ++a)
#pragma unroll
        for (int b = 0; b < 2; ++b)
#pragma unroll
            for (int m = 0; m < 4; ++m)
#pragma unroll
                for (int n = 0; n < 2; ++n) acc[a][b][m][n] = (f32x4){0.f, 0.f, 0.f, 0.f};
    bf16x8 At[4][2], B0[2][2], B1[2][2];
    const char* cA = GATHER ? (const char*)g.A : (const char*)g.A + (size_t)cur.pm * tstep; const char* cB = (const char*)g.Bt + (size_t)cur.pb * tstep;
    if constexpr (GATHER) { PG8_LOAD_GA(cur.ord); }
    PG8_STAGE(PG8_SB(0, 0), cB, voffB); PG8_STAGE(PG8_SB(0, 1), cB + hstep, voffB); PG8_STAGE_A(0, 0, cA); PG8_STAGE_A(0, 1, cA);
    if (wr == 1) PG8_BAR;
    PG8_WAIT_V(2); PG8_BAR;
    PG8_STAGE(PG8_SB(1, 0), cB + kstep, voffB); PG8_STAGE_A(1, 0, cA + kstep); PG8_STAGE(PG8_SB(1, 1), cB + hstep + kstep, voffB);
    PG8_WAIT_V(6); PG8_BAR;
    for (;;) {
        const bool has_next = S.next(ui + 1, nxt);
        const char* nA = GATHER ? (const char*)g.A : (has_next ? (const char*)g.A + (size_t)nxt.pm * tstep : cA); const char* nB = has_next ? (const char*)g.Bt + (size_t)nxt.pb * tstep : cB;
        for (int t = 0; t < nt; t += 2) {
            const bool last = (t == nt - 2);
            const char* a1 = cA + (size_t)(t + 1) * kstep;
            const char* a2 = last ? nA : cA + (size_t)(t + 2) * kstep; const char* b2 = last ? nB : cB + (size_t)(t + 2) * kstep;
            const char* a3 = a2 + kstep; const char* b3 = b2 + kstep;
            PG8_LDB(B0, 0, 0); PG8_LDB(B1, 0, 1); PG8_SCHED; PG8_LDA(At, 0, 0); PG8_STAGE_A(1, 1, a1);
            PG8_WAIT_V(8); PG8_WAIT_L(0); PG8_BAR; PG8_MMA(0, 0, At, B0); PG8_MMA(0, 1, At, B1); PG8_BAR; PG8_SCHED;
            if constexpr (GATHER) { if (last && has_next) { PG8_LOAD_GA(nxt.ord); } }
            PG8_LDA(At, 0, 1); PG8_STAGE(PG8_SB(0, 0), b2, voffB); PG8_STAGE(PG8_SB(0, 1), b2 + hstep, voffB); PG8_STAGE_A(0, 0, a2);
            PG8_WAIT_V(8); PG8_WAIT_L(0); PG8_BAR; PG8_MMA(1, 0, At, B0); PG8_MMA(1, 1, At, B1); PG8_BAR; PG8_SCHED;
            PG8_LDB(B0, 1, 0); PG8_LDB(B1, 1, 1); PG8_SCHED; PG8_LDA(At, 1, 0); PG8_STAGE_A(0, 1, a2);
            PG8_WAIT_V(8); PG8_WAIT_L(0); PG8_BAR; PG8_MMA(0, 0, At, B0); PG8_MMA(0, 1, At, B1); PG8_BAR; PG8_SCHED;
            PG8_LDA(At, 1, 1); PG8_STAGE(PG8_SB(1, 0), b3, voffB); PG8_STAGE(PG8_SB(1, 1), b3 + hstep, voffB); PG8_STAGE_A(1, 0, a3);
            PG8_WAIT_V(8); PG8_WAIT_L(0); PG8_BAR; PG8_MMA(1, 0, At, B0); PG8_MMA(1, 1, At, B1); PG8_BAR; PG8_SCHED;
        }
        if constexpr (ALIGN_EPI) { if (wr == 0) PG8_BAR; }
        E(acc, cur, wr, wc, fr, fq, ldsbase);
        if (!has_next) break;
#pragma unroll
        for (int a = 0; a < 2; ++a)
#pragma unroll
            for (int b = 0; b < 2; ++b)
#pragma unroll
                for (int m = 0; m < 4; ++m)
#pragma unroll
                    for (int n = 0; n < 2; ++n) acc[a][b][m][n] = (f32x4){0.f, 0.f, 0.f, 0.f};
        cur = nxt; cA = nA; cB = nB; ++ui;
        if constexpr (ALIGN_EPI) { if (wr == 1) PG8_BAR; }
    }
    PG8_WAIT_V(0);
    if constexpr (!ALIGN_EPI) { if (wr == 0) PG8_BAR; }
    PG8_BAR;
#undef PG8_SA
#undef PG8_SB
#undef PG8_STAGE
#undef PG8_STAGE_A
#undef PG8_LOAD_GA
#undef PG8_LDA
#undef PG8_LDB
#undef PG8_MMA
#undef PG8_WAIT_V
#undef PG8_WAIT_L
#undef PG8_BAR
#undef PG8_SCHED
}
}

constexpr int NWAVES = 8;
constexpr int T = 16384, D = 2048, SEQ = 2048, NB_PER_SEQ = 16;
constexpr int AH = 2048, NGRP = 16;
constexpr int NQH = 32, NKVH = 4, HD = 64, QKW = 2304, QKVW = 2560;
constexpr int NE = 64, NE1 = 65, TOPK = 8, EFF = 512;
constexpr int CAP = 16384;
constexpr int MAXRT = 704;
constexpr int NU_MAX = 12;
constexpr float LN_EPS = 1e-5f;
constexpr float DN_ALPHA = 1.41421356237309515f;
constexpr int N_PHASES = 15;

constexpr size_t MiB = 1u << 20;
constexpr size_t WS_CTL = 0, CTL_ZERO_BYTES = 1 * MiB;
constexpr size_t WS_WIN = 1 * MiB;
constexpr size_t WS_WOUT = WS_WIN + 16 * MiB;
constexpr size_t WS_WQKV = WS_WOUT + 8 * MiB;
constexpr size_t WS_WO = WS_WQKV + 10 * MiB;
constexpr size_t WS_WGU = WS_WO + 8 * MiB;
constexpr size_t WS_WD = WS_WGU + 520 * MiB;
constexpr size_t WS_RT = WS_WD + 260 * MiB;
constexpr size_t WS_HBUF = WS_RT + 2 * MiB;
constexpr size_t WS_XA = WS_HBUF + 128 * MiB;
constexpr size_t WS_U = WS_XA + 64 * MiB;
constexpr size_t WS_VT = WS_U + 72 * MiB;
constexpr size_t WS_GT = WS_VT + 64 * MiB;
constexpr size_t WS_H = WS_GT + 64 * MiB;
constexpr size_t WS_Y = WS_H + 160 * MiB;
constexpr size_t WS_STOK = WS_Y + 640 * MiB;
constexpr size_t WS_SW = WS_STOK + 4 * MiB;
constexpr size_t WS_TSLOT = WS_SW + 4 * MiB;
constexpr size_t WS_ST1 = WS_TSLOT + 1 * MiB;
constexpr size_t WS_VST = WS_ST1 + 1 * MiB;
constexpr size_t WS_END = WS_VST + 2 * MiB;
static_assert(WS_END <= (size_t)2048 * MiB, "d_ws map must fit 2 GiB");
constexpr int CW_TMO = 0, CW_CODE = 1;
constexpr int CW_CNT = 1024;
constexpr int CW_BAR = 4096;
constexpr int RING_OFF = 0, RING_BYTES = 131072;
constexpr int TAB_OFF = 131072;
constexpr int TAB_TILE_E = TAB_OFF, TAB_RTS = TAB_OFF + MAXRT * 4, TAB_CNT = TAB_RTS + 66 * 4, TAB_PST = TAB_CNT + 66 * 4, TAB_END = TAB_PST + 66 * 4;
constexpr int ROWTAB_OFF = 135168;
constexpr int ROWW_OFF = ROWTAB_OFF + NU_MAX * 1024;
constexpr int MISC_OFF = ROWW_OFF + NU_MAX * 1024;
constexpr int LDS_BYTES = 163840;
static_assert(TAB_END <= ROWTAB_OFF && MISC_OFF + 256 <= LDS_BYTES, "LDS map");

#define GAS __attribute__((address_space(1)))
#define LAS __attribute__((address_space(3)))
typedef unsigned short bf16;
typedef unsigned v4u __attribute__((ext_vector_type(4)));
typedef unsigned v2u __attribute__((ext_vector_type(2)));
typedef float f32x4 __attribute__((ext_vector_type(4)));
typedef float f32x2 __attribute__((ext_vector_type(2)));
typedef short bf16x8 __attribute__((ext_vector_type(8)));
typedef GAS unsigned gu32;
#define RLX_AGENT __ATOMIC_RELAXED, __HIP_MEMORY_SCOPE_AGENT
#define LDS_WAIT() asm volatile("s_waitcnt lgkmcnt(0)" ::: "memory")
#define VM_WAIT() asm volatile("s_waitcnt vmcnt(0)" ::: "memory")
__device__ __forceinline__ unsigned f2bf(float f) { unsigned u = __builtin_bit_cast(unsigned, f); return (u + 0x7fffu + ((u >> 16) & 1u)) >> 16; }
__device__ __forceinline__ unsigned pk2(float lo, float hi) { return f2bf(lo) | (f2bf(hi) << 16); }
__device__ __forceinline__ float bflo(unsigned w) { return __builtin_bit_cast(float, w << 16); }
__device__ __forceinline__ float bfhi(unsigned w) { return __builtin_bit_cast(float, w & 0xffff0000u); }

#define XB_TMO      128
#define XB_XCNT(j)  (256  + 64 * (j))
#define XB_XSUB(j)  (1280 + 64 * (j))
#define XB_XGEN(j)  (2304 + 64 * (j))
#define XB_TOP      3328
#define XB_TOPGEN   3392
#define XCD_BAR_WORDS 3456
#define XB_SPIN_CAP (1u << 18)
__device__ __forceinline__ unsigned xb_ld(unsigned* p)              { return __hip_atomic_load(p, __ATOMIC_RELAXED, __HIP_MEMORY_SCOPE_AGENT); }
__device__ __forceinline__ unsigned xb_add(unsigned* p, unsigned v) { return __hip_atomic_fetch_add(p, v, __ATOMIC_RELAXED, __HIP_MEMORY_SCOPE_AGENT); }
__device__ __forceinline__ unsigned xb_xcc_id() { return (unsigned)__builtin_amdgcn_s_getreg((3 << 11) | 20) & 0xFu; }
#define XB_SPIN(cond, bar) do { unsigned _sp = 0; while (cond) { __builtin_amdgcn_s_sleep(1); \
    if ((++_sp & 255u) == 0u) { if (xb_ld(&(bar)[XB_TMO])) break; if (_sp > XB_SPIN_CAP) { atomicAdd(&(bar)[XB_TMO], 1u); break; } } } } while (0)
struct XcdBarrier { unsigned* bar; unsigned x; volatile LAS unsigned* st; };
__device__ __forceinline__ XcdBarrier xcd_barrier_post(unsigned* bar, volatile LAS unsigned* st) {
    XcdBarrier b; b.bar = bar; b.x = xb_xcc_id(); b.st = st;
    if (threadIdx.x == 0) (void)xb_add(&bar[XB_XCNT(b.x)], 1u);
    return b;
}
__device__ __forceinline__ void xcd_barrier_complete(unsigned* bar, unsigned x, unsigned& nloc, unsigned& nx) {
    const unsigned G = gridDim.x * gridDim.y * gridDim.z;
    unsigned sum, cnt, mine, sp = 0u;
    for (;;) {
        sum = 0u; cnt = 0u; mine = 0u;
#pragma unroll
        for (unsigned j = 0; j < 16; ++j) { const unsigned c = xb_ld(&bar[XB_XCNT(j)]); sum += c; cnt += (c > 0u) ? 1u : 0u; mine = (j == x) ? c : mine; }
        if (sum == G) break;
        __builtin_amdgcn_s_sleep(1);
        if ((++sp & 255u) == 0u) { if (xb_ld(&bar[XB_TMO])) break; if (sp > XB_SPIN_CAP) { atomicAdd(&bar[XB_TMO], 1u); break; } }
    }
    nloc = mine > 0u ? mine : 1u; nx = cnt > 0u ? cnt : 1u;
}
__device__ __forceinline__ void xcd_barrier(const XcdBarrier& b) {
    asm volatile("s_waitcnt vmcnt(0)" ::: "memory");
    __syncthreads();
    if (threadIdx.x == 0) {
        unsigned* bar = b.bar;
        __builtin_amdgcn_s_waitcnt(0);
        unsigned nloc = b.st[0], nx = b.st[1];
        if (nloc == 0u) { xcd_barrier_complete(bar, b.x, nloc, nx); b.st[0] = nloc; b.st[1] = nx; }
        const unsigned old = xb_add(&bar[XB_XSUB(b.x)], 1u);
        const unsigned gen = old / nloc;
        if (old + 1u == (gen + 1u) * nloc) {
            __builtin_amdgcn_fence(__ATOMIC_RELEASE, "agent");
            asm volatile("s_waitcnt vmcnt(0)" ::: "memory");
            const unsigned og = xb_add(&bar[XB_TOP], 1u);
            const unsigned tg = og / nx;
            if (og + 1u == (tg + 1u) * nx) xb_add(&bar[XB_TOPGEN], 1u);
            else XB_SPIN(xb_ld(&bar[XB_TOPGEN]) == tg, bar);
            __builtin_amdgcn_fence(__ATOMIC_ACQUIRE, "agent");
            xb_add(&bar[XB_XGEN(b.x)], 1u);
            asm volatile("s_waitcnt vmcnt(0)" ::: "memory");
        } else {
            XB_SPIN(xb_ld(&bar[XB_XGEN(b.x)]) == gen, bar);
            __builtin_amdgcn_fence(__ATOMIC_ACQUIRE, "agent");
            asm volatile("s_waitcnt vmcnt(0)" ::: "memory");
        }
    }
    __syncthreads();
}

struct Frame {
    LAS unsigned char* lds;
    volatile LAS unsigned* MISC;
    gu32* ctl;
    int tid, lane, wave;
    int vcu, G;
    unsigned char* ws;
};
struct Args { const float* in[23]; float* out; unsigned char* ws; int ph_lo, ph_hi; };
enum { I_X = 0, I_AWIN, I_ABIN, I_ALNG, I_ALNB, I_AWS, I_ABS, I_AWOUT, I_BWQKV, I_BBQKV, I_BSINK, I_BWO, I_BBO,
       I_MWR, I_MRB, I_MWG, I_MWU, I_MWD, I_SWG, I_SWU, I_SWD, I_NG, I_NB };

__device__ __forceinline__ float wave_sum(float v) {
#pragma unroll
    for (int o = 1; o < 64; o <<= 1) v += __shfl_xor(v, o);
    return v;
}

__device__ __forceinline__ void p0_transpose_item(const float* W, int N, bf16* WT, int Kd, int k0, int n0, int drow0, LAS float* scr, int lane) {
#pragma unroll 8
    for (int i = 0; i < 32; ++i) { const int kk = 2 * i + (lane >> 5); scr[kk * 33 + (lane & 31)] = W[(size_t)(k0 + kk) * N + n0 + (lane & 31)]; }
    LDS_WAIT(); asm volatile("" ::: "memory");
    const int c = lane & 7;
#pragma unroll
    for (int j = 0; j < 4; ++j) { const int n = (lane >> 3) + 8 * j; const LAS float* s = scr + (8 * c) * 33 + n;
        v4u o; o.x = pk2(s[0 * 33], s[1 * 33]); o.y = pk2(s[2 * 33], s[3 * 33]); o.z = pk2(s[4 * 33], s[5 * 33]); o.w = pk2(s[6 * 33], s[7 * 33]);
        *(GAS v4u*)(WT + (size_t)(drow0 + n) * Kd + k0 + 8 * c) = o; }
    LDS_WAIT(); asm volatile("" ::: "memory");
}
__device__ __forceinline__ void p0_prologue(Frame& F, const Args& AR) {
    LAS float* scr = (LAS float*)(F.lds + RING_OFF + F.wave * 16384);
    const int gw = F.vcu * NWAVES + F.wave, NGW = F.G * NWAVES;
    bf16* Win_t = (bf16*)(F.ws + WS_WIN); bf16* Wout_t = (bf16*)(F.ws + WS_WOUT); bf16* Wqkv_t = (bf16*)(F.ws + WS_WQKV); bf16* Wo_t = (bf16*)(F.ws + WS_WO);
    bf16* Wgu_t = (bf16*)(F.ws + WS_WGU); bf16* Wd_t = (bf16*)(F.ws + WS_WD);
    constexpr int J_WIN = 32 * 128, J_WOUT = 32 * 64, J_WQKV = 32 * 80, J_WO = 32 * 64;
    constexpr int J_GU = 32 * 16;
    constexpr int J_DN = 8 * 64;
    constexpr int N_MOE = 2 * NE;
    constexpr int B0 = 0, B1 = B0 + J_WIN, B2 = B1 + J_WOUT, B3 = B2 + J_WQKV, B4 = B3 + J_WO;
    constexpr int B5 = B4 + N_MOE * J_GU;
    constexpr int B6 = B5 + N_MOE * J_GU;
    constexpr int B7 = B6 + N_MOE * J_DN;
    constexpr int B8 = B7 + 2 * J_GU;
    constexpr int B9 = B8 + 2 * J_GU;
    constexpr int B10 = B9 + 2 * J_DN;
    for (int it = gw; it < B10; it += NGW) {
        if (it < B1) { const int r = it - B0, kb = r / 128, nb = r % 128; p0_transpose_item(AR.in[I_AWIN], 4096, Win_t, 2048, 64 * kb, 32 * nb, 32 * nb, scr, F.lane); }
        else if (it < B2) { const int r = it - B1, kb = r / 64, nb = r % 64; p0_transpose_item(AR.in[I_AWOUT], 2048, Wout_t, 2048, 64 * kb, 32 * nb, 32 * nb, scr, F.lane); }
        else if (it < B3) { const int r = it - B2, kb = r / 80, nb = r % 80; p0_transpose_item(AR.in[I_BWQKV], 2560, Wqkv_t, 2048, 64 * kb, 32 * nb, 32 * nb, scr, F.lane); }
        else if (it < B4) { const int r = it - B3, kb = r / 64, nb = r % 64; p0_transpose_item(AR.in[I_BWO], 2048, Wo_t, 2048, 64 * kb, 32 * nb, 32 * nb, scr, F.lane); }
        else if (it < B6) { const bool up = it >= B5; const int r = it - (up ? B5 : B4), mat = r / J_GU, q = r % J_GU, kb = q / 16, nb = q % 16, l = mat / NE, e = mat % NE;
            const float* src = AR.in[up ? I_MWU : I_MWG] + (size_t)mat * 2048 * 512; bf16* dst = Wgu_t + ((size_t)(l * NE1 + e)) * 1024 * 2048;
            const int n0 = 32 * nb, drow0 = (n0 >> 7) * 256 + (up ? 128 : 0) + (n0 & 127);
            p0_transpose_item(src, 512, dst, 2048, 64 * kb, n0, drow0, scr, F.lane); }
        else if (it < B7) { const int r = it - B6, mat = r / J_DN, q = r % J_DN, kb = q / 64, nb = q % 64, l = mat / NE, e = mat % NE;
            const float* src = AR.in[I_MWD] + (size_t)mat * 512 * 2048; bf16* dst = Wd_t + ((size_t)(l * NE1 + e)) * 2048 * 512;
            p0_transpose_item(src, 2048, dst, 512, 64 * kb, 32 * nb, 32 * nb, scr, F.lane); }
        else if (it < B9) { const bool up = it >= B8; const int r = it - (up ? B8 : B7), l = r / J_GU, q = r % J_GU, kb = q / 16, nb = q % 16;
            const float* src = AR.in[up ? I_SWU : I_SWG] + (size_t)l * 2048 * 512; bf16* dst = Wgu_t + ((size_t)(l * NE1 + NE)) * 1024 * 2048;
            const int n0 = 32 * nb, drow0 = (n0 >> 7) * 256 + (up ? 128 : 0) + (n0 & 127);
            p0_transpose_item(src, 512, dst, 2048, 64 * kb, n0, drow0, scr, F.lane); }
        else { const int r = it - B9, l = r / J_DN, q = r % J_DN, kb = q / 64, nb = q % 64;
            const float* src = AR.in[I_SWD] + (size_t)l * 512 * 2048; bf16* dst = Wd_t + ((size_t)(l * NE1 + NE)) * 2048 * 512;
            p0_transpose_item(src, 2048, dst, 512, 64 * kb, 32 * nb, 32 * nb, scr, F.lane); }
    }
    { const GAS f32x4* xs = (const GAS f32x4*)AR.in[I_X]; GAS v4u* xd = (GAS v4u*)(F.ws + WS_XA); const size_t n8 = (size_t)T * D / 8;
      for (size_t i = (size_t)gw * 64 + F.lane; i < n8; i += (size_t)NGW * 64) { const f32x4 a = xs[2 * i], b = xs[2 * i + 1]; v4u o; o.x = pk2(a.x, a.y); o.y = pk2(a.z, a.w); o.z = pk2(b.x, b.y); o.w = pk2(b.z, b.w); xd[i] = o; } }
    if (F.vcu < 2) {
        __syncthreads();
        const int l = F.vcu, e = F.tid & 63, dg = F.tid >> 6;
        const float* Wr = AR.in[I_MWR] + (size_t)l * 2048 * 64; const float* g0 = AR.in[I_NG] + (size_t)(l * 2 + 0) * 2048; const float* b0 = AR.in[I_NB] + (size_t)(l * 2 + 0) * 2048;
        float* Wrp = (float*)(F.ws + WS_RT) + (size_t)l * 2048 * 64; float* c1 = (float*)(F.ws + WS_RT + 1 * MiB) + l * 64; float* c0 = (float*)(F.ws + WS_RT + 1 * MiB) + 128 + l * 64;
        float s1 = 0.f, s0 = 0.f;
        for (int d = dg * 256; d < dg * 256 + 256; ++d) { const float w = Wr[(size_t)d * 64 + e]; const float wp = g0[d] * w; Wrp[(size_t)d * 64 + e] = wp; s1 += wp; s0 += b0[d] * w; }
        LAS float* red = (LAS float*)(F.lds + RING_OFF);
        __syncthreads();
        red[dg * 64 + e] = s1; red[512 + dg * 64 + e] = s0;
        __syncthreads();
        if (F.tid < 64) { float a = 0.f, b = 0.f;
#pragma unroll
            for (int k = 0; k < 8; ++k) { a += red[k * 64 + e]; b += red[512 + k * 64 + e]; }
            c1[e] = a; c0[e] = b; }
        __syncthreads();
    }
}

__device__ __forceinline__ void p2_sgu(Frame& F, const Args& AR) {
    LAS float* s_mu = (LAS float*)(F.lds + RING_OFF);
    LAS float* s_rs = (LAS float*)(F.lds + RING_OFF + 512);
    LAS bf16* vt = (LAS bf16*)(F.lds + RING_OFF + 1024);
    const bf16* VT = (const bf16*)(F.ws + WS_VT); const bf16* U = (const bf16*)(F.ws + WS_U); bf16* GT = (bf16*)(F.ws + WS_GT);
    const float* vstat = (const float*)(F.ws + WS_VST);
    const float* Wsp = AR.in[I_AWS]; const float* bsp = AR.in[I_ABS]; const float* lng = AR.in[I_ALNG]; const float* lnb = AR.in[I_ALNB];
    const int fr = F.lane & 15, fq = F.lane >> 4, w = F.wave;
    for (int item = F.vcu; item < 256; item += F.G) {
        const int chunk = item >> 1, gh = item & 1, tok0 = chunk * 128;
        __syncthreads();
        if (F.tid < 128) { float a = 0.f, b = 0.f;
#pragma unroll
            for (int P = 0; P < 16; ++P) { const f32x2 v = *(const f32x2*)(vstat + ((size_t)P * T + tok0 + F.tid) * 2); a += v.x; b += v.y; }
            const float mean = a * (1.0f / AH); const float var = b * (1.0f / AH) - mean * mean; s_mu[F.tid] = mean; s_rs[F.tid] = 1.0f / sqrtf(var + LN_EPS); }
        for (int gi = 0; gi < 8; ++gi) {
            const int g = gh * 8 + gi;
            __syncthreads();
#pragma unroll
            for (int k = 0; k < 4; ++k) { const int p = F.tid + 512 * k, c = p >> 4, sp = p & 15;
                *(LAS v4u*)(vt + c * 136 + sp * 8) = *(const GAS v4u*)(VT + (size_t)(g * 128 + c) * T + tok0 + sp * 8); }
            __syncthreads();
            const int t = 16 * w + fr;
            f32x4 acc[8];
#pragma unroll
            for (int cb = 0; cb < 8; ++cb) acc[cb] = (f32x4){0.f, 0.f, 0.f, 0.f};
            float c1 = 0.f, c2 = 0.f;
            const int nks = (16 * w + 15) / 32 + 1;
#pragma unroll
            for (int ks = 0; ks < 4; ++ks) { if (ks < nks) {
                const int s0 = 32 * ks + 8 * fq;
                const float* wp = Wsp + ((size_t)g * 128 + t) * 128 + s0;
                const f32x4 wa = *(const f32x4*)wp, wb = *(const f32x4*)(wp + 4);
                const f32x4 ra = *(const LAS f32x4*)(s_rs + s0), rb = *(const LAS f32x4*)(s_rs + s0 + 4);
                const f32x4 ma = *(const LAS f32x4*)(s_mu + s0), mb = *(const LAS f32x4*)(s_mu + s0 + 4);
                float wv[8], rv[8], mv[8], wq[8];
#pragma unroll
                for (int j = 0; j < 4; ++j) { wv[j] = wa[j]; wv[4 + j] = wb[j]; rv[j] = ra[j]; rv[4 + j] = rb[j]; mv[j] = ma[j]; mv[4 + j] = mb[j]; }
#pragma unroll
                for (int j = 0; j < 8; ++j) { const float w0 = (s0 + j <= t) ? wv[j] : 0.f; c2 += w0; wq[j] = w0 * rv[j]; c1 += wq[j] * mv[j]; }
                v4u yp; yp.x = pk2(wq[0], wq[1]); yp.y = pk2(wq[2], wq[3]); yp.z = pk2(wq[4], wq[5]); yp.w = pk2(wq[6], wq[7]);
                const bf16x8 Y = __builtin_bit_cast(bf16x8, yp);
#pragma unroll
                for (int cb = 0; cb < 8; ++cb) { const bf16x8 X = *(const LAS bf16x8*)(vt + (16 * cb + fr) * 136 + 32 * ks + 8 * fq);
                    acc[cb] = __builtin_amdgcn_mfma_f32_16x16x32_bf16(X, Y, acc[cb], 0, 0, 0); }
            } }
            c1 += __shfl_xor(c1, 16); c1 += __shfl_xor(c1, 32); c2 += __shfl_xor(c2, 16); c2 += __shfl_xor(c2, 32);
            const float bsv = bsp[g * 128 + t];
            const size_t rowoff = (size_t)(tok0 + t) * AH;
#pragma unroll
            for (int cb = 0; cb < 8; ++cb) { const int j0 = g * 128 + 16 * cb + 4 * fq;
                const f32x4 g4 = *(const f32x4*)(lng + j0), b4 = *(const f32x4*)(lnb + j0);
                const v2u uu = *(const GAS v2u*)(U + rowoff + j0);
                const float u0 = bflo(uu.x), u1 = bfhi(uu.x), u2 = bflo(uu.y), u3 = bfhi(uu.y);
                const float o0 = (g4[0] * (acc[cb][0] - c1) + b4[0] * c2 + bsv) * u0, o1 = (g4[1] * (acc[cb][1] - c1) + b4[1] * c2 + bsv) * u1;
                const float o2 = (g4[2] * (acc[cb][2] - c1) + b4[2] * c2 + bsv) * u2, o3 = (g4[3] * (acc[cb][3] - c1) + b4[3] * c2 + bsv) * u3;
                v2u o; o.x = pk2(o0, o1); o.y = pk2(o2, o3);
                *(GAS v2u*)(GT + rowoff + j0) = o; }
        }
    }
    __syncthreads();
}

__device__ __forceinline__ void attn_phase(Frame& F, const Args& AR) {
    LAS bf16* kt = (LAS bf16*)(F.lds + RING_OFF);
    LAS bf16* vtt = (LAS bf16*)(F.lds + RING_OFF + 36864);
    const bf16* QK = (const bf16*)(F.ws + WS_U); const bf16* VTA = (const bf16*)(F.ws + WS_VT); bf16* O = (bf16*)(F.ws + WS_GT);
    const float* sinks = AR.in[I_BSINK];
    const int fr = F.lane & 15, fq = F.lane >> 4, w = F.wave;
    const float LOG2E = 1.44269504089f;
    for (int unit = F.vcu; unit < 512; unit += F.G) {
        const int kvh = unit & 3, nbb = unit >> 2, nb = nbb & 15, tok0 = nbb * 128;
        __syncthreads();
#pragma unroll
        for (int k = 0; k < 4; ++k) { const int p = F.tid + 512 * k, key = p >> 3, pc = p & 7; const bool valid = (nb > 0) || key >= 128;
            v4u val = (v4u){0u, 0u, 0u, 0u}; if (valid) val = *(const GAS v4u*)(QK + (size_t)(tok0 - 128 + key) * QKW + 2048 + kvh * 64 + pc * 8);
            *(LAS v4u*)(kt + key * 72 + pc * 8) = val; }
#pragma unroll
        for (int k = 0; k < 4; ++k) { const int p = F.tid + 512 * k, d = p >> 5, pc = p & 31, key0 = pc * 8; const bool valid = (nb > 0) || key0 >= 128;
            v4u val = (v4u){0u, 0u, 0u, 0u}; if (valid) val = *(const GAS v4u*)(VTA + (size_t)(kvh * 64 + d) * T + tok0 - 128 + key0);
            *(LAS v4u*)(vtt + d * 264 + key0) = val; }
        __syncthreads();
        const int hq = kvh * 8 + w; const float slope = exp2f(-(float)(hq + 1) * 0.25f); const float sink = sinks[hq];
        for (int qc = 0; qc < 8; ++qc) {
            const int i = 16 * qc + fr; const size_t tokq = (size_t)(tok0 + i);
            const bf16x8 q0 = *(const GAS bf16x8*)(QK + tokq * QKW + hq * 64 + 8 * fq), q1 = *(const GAS bf16x8*)(QK + tokq * QKW + hq * 64 + 32 + 8 * fq);
            f32x4 s[9];
#pragma unroll
            for (int kk = 0; kk < 9; ++kk) { const int kb = qc + kk; s[kk] = (f32x4){0.f, 0.f, 0.f, 0.f};
                const bf16x8 X0 = *(const LAS bf16x8*)(kt + (16 * kb + fr) * 72 + 8 * fq), X1 = *(const LAS bf16x8*)(kt + (16 * kb + fr) * 72 + 32 + 8 * fq);
                s[kk] = __builtin_amdgcn_mfma_f32_16x16x32_bf16(X0, q0, s[kk], 0, 0, 0); s[kk] = __builtin_amdgcn_mfma_f32_16x16x32_bf16(X1, q1, s[kk], 0, 0, 0); }
            float mx = sink;
#pragma unroll
            for (int kk = 0; kk < 9; ++kk)
#pragma unroll
                for (int r = 0; r < 4; ++r) { const int jj = 16 * (qc + kk) + 4 * fq + r; const int dist = i + 128 - jj; const bool valid = (dist >= 0) && (dist < 128) && ((nb > 0) || (jj >= 128));
                    const float sc = valid ? (s[kk][r] - slope * (float)dist) : -INFINITY; s[kk][r] = sc; mx = fmaxf(mx, sc); }
            mx = fmaxf(mx, __shfl_xor(mx, 16)); mx = fmaxf(mx, __shfl_xor(mx, 32));
            float sum = 0.f;
#pragma unroll
            for (int kk = 0; kk < 9; ++kk)
#pragma unroll
                for (int r = 0; r < 4; ++r) { const float e = exp2f((s[kk][r] - mx) * LOG2E); s[kk][r] = e; sum += e; }
            sum += __shfl_xor(sum, 16); sum += __shfl_xor(sum, 32);
            sum += exp2f((sink - mx) * LOG2E);
            const float inv = 1.0f / sum;
            v2u pk[10];
#pragma unroll
            for (int kk = 0; kk < 9; ++kk) { pk[kk].x = pk2(s[kk][0] * inv, s[kk][1] * inv); pk[kk].y = pk2(s[kk][2] * inv, s[kk][3] * inv); }
            pk[9] = (v2u){0u, 0u};
            f32x4 o[4];
#pragma unroll
            for (int db = 0; db < 4; ++db) o[db] = (f32x4){0.f, 0.f, 0.f, 0.f};
#pragma unroll
            for (int st = 0; st < 5; ++st) { const int ka = 2 * st, kb2 = (2 * st + 1 < 9) ? 2 * st + 1 : 2 * st;
                v4u yp; yp.x = pk[2 * st].x; yp.y = pk[2 * st].y; yp.z = pk[2 * st + 1].x; yp.w = pk[2 * st + 1].y;
                const bf16x8 Y = __builtin_bit_cast(bf16x8, yp);
#pragma unroll
                for (int db = 0; db < 4; ++db) { const v2u xa = *(const LAS v2u*)(vtt + (16 * db + fr) * 264 + 16 * (qc + ka) + 4 * fq), xb = *(const LAS v2u*)(vtt + (16 * db + fr) * 264 + 16 * (qc + kb2) + 4 * fq);
                    v4u xp; xp.x = xa.x; xp.y = xa.y; xp.z = xb.x; xp.w = xb.y;
                    o[db] = __builtin_amdgcn_mfma_f32_16x16x32_bf16(__builtin_bit_cast(bf16x8, xp), Y, o[db], 0, 0, 0); } }
#pragma unroll
            for (int db = 0; db < 4; ++db) { v2u ov; ov.x = pk2(o[db][0], o[db][1]); ov.y = pk2(o[db][2], o[db][3]);
                *(GAS v2u*)(O + tokq * D + hq * 64 + 16 * db + 4 * fq) = ov; }
        }
    }
    __syncthreads();
}

__device__ __forceinline__ void moe_tables(Frame& F, int layer) {
    LAS int* tile_e = (LAS int*)(F.lds + TAB_TILE_E); LAS int* rts = (LAS int*)(F.lds + TAB_RTS); LAS int* cntl = (LAS int*)(F.lds + TAB_CNT); LAS int* pst = (LAS int*)(F.lds + TAB_PST);
    __syncthreads();
    if (F.tid < NE) { int c = (int)__hip_atomic_load((unsigned*)(F.ctl + CW_CNT + layer * 64 + F.tid), RLX_AGENT); if (c > CAP) c = CAP; cntl[F.tid] = c; }
    if (F.tid == NE) cntl[NE] = T;
    __syncthreads();
    if (F.tid == 0) { int acc = 0; for (int e = 0; e < NE1; ++e) { rts[e] = acc; pst[e] = acc * 256; acc += (cntl[e] + 255) >> 8; } rts[NE1] = acc; pst[NE1] = acc * 256; }
    __syncthreads();
    for (int e = F.tid >> 3; e < NE1; e += 64) { const int a = rts[e], b = rts[e + 1]; for (int rt = a + (F.tid & 7); rt < b; rt += 8) tile_e[rt] = e; }
    __syncthreads();
}
template <bool GATHER_> struct MoeOrder {
    static constexpr bool GATHER = GATHER_;
    pg8::StaticOrder so; LAS unsigned char* lds; int nNb;
    __device__ __forceinline__ void init(LAS unsigned char* lds_, int nN, int G, int c) { lds = lds_; nNb = nN; const int nrt = ((const LAS int*)(lds + TAB_RTS))[NE1]; so.init(nrt, nN, G, c); }
    __device__ __forceinline__ bool next(int i, pg8::Unit& u) const {
        if (i >= NU_MAX * (GATHER_ ? 1 : 4)) return false;
        if (!so.map(i, u.pm, u.pn)) return false;
        const int e = ((const LAS int*)(lds + TAB_TILE_E))[u.pm]; u.pb = e * nNb + u.pn; u.ord = i; return true; }
    __device__ __forceinline__ unsigned rowoff(int ord, int r) const { return ((const LAS unsigned*)(lds + ROWTAB_OFF))[ord * 256 + r]; }
    __device__ __forceinline__ void prepare(const int* slot_tok, const float* slot_w, int Kbytes, int tid) const {
        const LAS int* tile_e = (const LAS int*)(lds + TAB_TILE_E); const LAS int* rts = (const LAS int*)(lds + TAB_RTS); const LAS int* cntl = (const LAS int*)(lds + TAB_CNT);
        LAS unsigned* rowtab = (LAS unsigned*)(lds + ROWTAB_OFF); LAS float* roww = (LAS float*)(lds + ROWW_OFF);
        const int r = tid & 255;
        for (int i = tid >> 8; i < NU_MAX; i += 2) { int pm, pn; if (!so.map(i, pm, pn)) break;
            const int e = tile_e[pm]; const int pos = (pm - rts[e]) * 256 + r; int tok = 0; float w = 0.f;
            if (e == NE) { tok = pos; w = 1.f; } else if (pos < cntl[e]) { tok = slot_tok[(size_t)e * CAP + pos]; w = slot_w[(size_t)e * CAP + pos]; }
            rowtab[i * 256 + r] = (unsigned)tok * (unsigned)Kbytes; roww[i * 256 + r] = w; }
        __syncthreads();
    }
};

__device__ __forceinline__ void moe_route(Frame& F, const Args& AR, int layer) {
    LAS float* hc = (LAS float*)(F.lds + RING_OFF);
    LAS float* wrc = (LAS float*)(F.lds + RING_OFF + 33280);
    LAS float* lg = (LAS float*)(F.lds + RING_OFF + 74240);
    LAS unsigned* lcnt = (LAS unsigned*)(F.lds + RING_OFF + 90624);
    LAS unsigned* lbase = (LAS unsigned*)(F.lds + RING_OFF + 90880);
    LAS float* rst = (LAS float*)(F.lds + RING_OFF + 91136);
    LAS unsigned* tsel = (LAS unsigned*)(F.lds + RING_OFF + 91648);
    LAS float* tselw = (LAS float*)(F.lds + RING_OFF + 93696);
    const float* hbuf = (const float*)(F.ws + WS_HBUF); bf16* xa = (bf16*)(F.ws + WS_XA); float* stats1 = (float*)(F.ws + WS_ST1);
    const float* Wrp = (const float*)(F.ws + WS_RT) + (size_t)layer * 2048 * 64; const float* c1 = (const float*)(F.ws + WS_RT + 1 * MiB) + layer * 64; const float* c0 = (const float*)(F.ws + WS_RT + 1 * MiB) + 128 + layer * 64;
    const float* g0 = AR.in[I_NG] + (size_t)(layer * 2 + 0) * 2048; const float* b0 = AR.in[I_NB] + (size_t)(layer * 2 + 0) * 2048; const float* rbias = AR.in[I_MRB] + layer * 64;
    int* slot_tok = (int*)(F.ws + WS_STOK); float* slot_w = (float*)(F.ws + WS_SW); int* tok_slot = (int*)(F.ws + WS_TSLOT);
    unsigned* gcnt = (unsigned*)(F.ctl + CW_CNT + layer * 64);
    const int fr = F.lane & 15, fq = F.lane >> 4, w = F.wave;
    for (int blk = F.vcu; blk < T / 64; blk += F.G) {
        const int row0 = blk * 64;
        __syncthreads();
        if (F.tid < 64) lcnt[F.tid] = 0u;
        f32x4 racc[2]; racc[0] = (f32x4){0.f, 0.f, 0.f, 0.f}; racc[1] = (f32x4){0.f, 0.f, 0.f, 0.f};
        float ps = 0.f, pq = 0.f;
        const int lrow = F.tid >> 3, sub = F.tid & 7, rb = w >> 1, eb0 = (w & 1) * 2;
        for (int ch = 0; ch < 16; ++ch) {
            __syncthreads();
#pragma unroll
            for (int q = 0; q < 4; ++q) { const int c4 = sub + 8 * q; const f32x4 v = *(const GAS f32x4*)(hbuf + (size_t)(row0 + lrow) * D + ch * 128 + c4 * 4);
                ps += (v.x + v.y) + (v.z + v.w); pq += (v.x * v.x + v.y * v.y) + (v.z * v.z + v.w * v.w);
                LAS f32x2* dst = (LAS f32x2*)(hc + lrow * 130 + c4 * 4); dst[0] = (f32x2){v.x, v.y}; dst[1] = (f32x2){v.z, v.w}; }
#pragma unroll
            for (int q = 0; q < 4; ++q) { const int idx = F.tid + 512 * q, d = idx >> 4, e4 = idx & 15; *(LAS f32x4*)(wrc + d * 80 + e4 * 4) = *(const GAS f32x4*)(Wrp + (size_t)(ch * 128 + d) * 64 + e4 * 4); }
            __syncthreads();
#pragma unroll 8
            for (int ks = 0; ks < 32; ++ks) { const float a = hc[(rb * 16 + fr) * 130 + 4 * ks + fq];
                const float bA = wrc[(4 * ks + fq) * 80 + eb0 * 16 + fr], bB = wrc[(4 * ks + fq) * 80 + (eb0 + 1) * 16 + fr];
                racc[0] = __builtin_amdgcn_mfma_f32_16x16x4f32(a, bA, racc[0], 0, 0, 0); racc[1] = __builtin_amdgcn_mfma_f32_16x16x4f32(a, bB, racc[1], 0, 0, 0); }
        }
        ps += pg8::dppf<0xB1>(ps); ps += pg8::dppf<0x4E>(ps); ps += pg8::dppf<0x141>(ps);
        pq += pg8::dppf<0xB1>(pq); pq += pg8::dppf<0x4E>(pq); pq += pg8::dppf<0x141>(pq);
        if (sub == 0) { const float mean = ps * (1.0f / D); const float var = pq * (1.0f / D) - mean * mean; const float rstd = 1.0f / sqrtf(var + LN_EPS);
            rst[lrow * 2] = mean; rst[lrow * 2 + 1] = rstd; *(GAS f32x2*)(stats1 + (size_t)(row0 + lrow) * 2) = (f32x2){mean, rstd}; }
        __syncthreads();
#pragma unroll
        for (int n = 0; n < 2; ++n) { const int e = (eb0 + n) * 16 + fr; const float c1e = c1[e], c0e = c0[e];
#pragma unroll
            for (int r = 0; r < 4; ++r) { const int row = rb * 16 + 4 * fq + r; lg[row * 64 + e] = rst[row * 2 + 1] * (racc[n][r] - rst[row * 2] * c1e) + c0e; } }
        __syncthreads();
        for (int rr = 0; rr < 8; ++rr) {
            const int row = 8 * w + rr; const float mean = rst[row * 2], rstd = rst[row * 2 + 1];
            const size_t ro = (size_t)(row0 + row) * D;
#pragma unroll
            for (int j = 0; j < 4; ++j) { const int c = 512 * j + 8 * F.lane;
                const f32x4 ha = *(const GAS f32x4*)(hbuf + ro + c), hb = *(const GAS f32x4*)(hbuf + ro + c + 4);
                const f32x4 ga = *(const f32x4*)(g0 + c), gb = *(const f32x4*)(g0 + c + 4), ba = *(const f32x4*)(b0 + c), bb = *(const f32x4*)(b0 + c + 4);
                const f32x4 xa4 = (ha - mean) * rstd * ga + ba, xb4 = (hb - mean) * rstd * gb + bb;
                v4u o; o.x = pk2(xa4.x, xa4.y); o.y = pk2(xa4.z, xa4.w); o.z = pk2(xb4.x, xb4.y); o.w = pk2(xb4.z, xb4.w);
                *(GAS v4u*)(xa + ro + c) = o; }
            const float logit = lg[row * 64 + F.lane];
            const float score = 1.0f / (1.0f + __expf(-logit));
            const float sel = score + rbias[F.lane];
            float m1 = sel; m1 = fmaxf(m1, pg8::dppf<0xB1>(m1)); m1 = fmaxf(m1, pg8::dppf<0x4E>(m1)); m1 = fmaxf(m1, pg8::dppf<0x141>(m1));
            const unsigned long long eq = __ballot(sel == m1); const int gsh = F.lane & ~7; const unsigned gm = (unsigned)((eq >> gsh) & 0xffull);
            const int first = gsh + __builtin_ctz(gm | 0x100u);
            float m2 = (F.lane == first) ? -INFINITY : sel; m2 = fmaxf(m2, pg8::dppf<0xB1>(m2)); m2 = fmaxf(m2, pg8::dppf<0x4E>(m2)); m2 = fmaxf(m2, pg8::dppf<0x141>(m2));
            const float gs = m1 + m2; const int g = F.lane >> 3; int grank = 0;
#pragma unroll
            for (int gg = 0; gg < 8; ++gg) { const float s = __builtin_bit_cast(float, __builtin_amdgcn_readlane(__builtin_bit_cast(int, gs), gg * 8)); grank += ((s > gs) || (s == gs && gg < g)) ? 1 : 0; }
            const float mv = (grank < 4) ? sel : -INFINITY; int rk = 0;
#pragma unroll 16
            for (int l = 0; l < 64; ++l) { const float s = __builtin_bit_cast(float, __builtin_amdgcn_readlane(__builtin_bit_cast(int, mv), l)); rk += ((s > mv) || (s == mv && l < F.lane)) ? 1 : 0; }
            const bool chosen = rk < 8;
            float wt = chosen ? score : 0.f; const float wsum = wave_sum(wt); wt = wt / (wsum + 1e-20f) * 2.5f;
            const unsigned long long cm = __ballot(chosen);
            if (chosen) { const int k = __builtin_popcountll(cm & ((1ull << F.lane) - 1ull)); const unsigned lr = __hip_atomic_fetch_add(&lcnt[F.lane], 1u, __ATOMIC_RELAXED, __HIP_MEMORY_SCOPE_WORKGROUP);
                if (k < 8) { tsel[row * 8 + k] = ((unsigned)F.lane << 16) | lr; tselw[row * 8 + k] = wt; } }
        }
        __syncthreads();
        if (F.tid < 64) lbase[F.tid] = __hip_atomic_fetch_add(gcnt + F.tid, lcnt[F.tid], RLX_AGENT);
        __syncthreads();
        { const int row = F.tid >> 3, k = F.tid & 7; const unsigned v = tsel[row * 8 + k]; const int e = (int)(v >> 16); const unsigned pos = lbase[e] + (v & 0xffffu);
          const int tok = row0 + row;
          if (pos < (unsigned)CAP) { slot_tok[(size_t)e * CAP + pos] = tok; slot_w[(size_t)e * CAP + pos] = tselw[row * 8 + k]; }
          tok_slot[(size_t)tok * 8 + k] = e * CAP + (int)(pos < (unsigned)CAP ? pos : CAP - 1); }
    }
    __syncthreads();
}

__device__ __forceinline__ void moe_combine(Frame& F, const Args& AR, int layer) {
    float* hbuf = (float*)(F.ws + WS_HBUF); bf16* xa = (bf16*)(F.ws + WS_XA); const float* stats1 = (const float*)(F.ws + WS_ST1);
    const bf16* Y = (const bf16*)(F.ws + WS_Y); const int* tok_slot = (const int*)(F.ws + WS_TSLOT);
    const float* g0 = AR.in[I_NG] + (size_t)(layer * 2 + 0) * 2048; const float* b0 = AR.in[I_NB] + (size_t)(layer * 2 + 0) * 2048;
    const float* g1 = AR.in[I_NG] + (size_t)(layer * 2 + 1) * 2048; const float* b1 = AR.in[I_NB] + (size_t)(layer * 2 + 1) * 2048;
    const LAS int* pst = (const LAS int*)(F.lds + TAB_PST);
    const int gw = F.vcu * NWAVES + F.wave, NGW = F.G * NWAVES;
    for (int tok = gw; tok < T; tok += NGW) {
        int myrow = 0;
        if (F.lane < 8) { const int ts = tok_slot[(size_t)tok * 8 + F.lane]; myrow = pst[ts >> 14] + (ts & (CAP - 1)); }
        if (F.lane == 8) myrow = pst[NE] + tok;
        int rows[9];
#pragma unroll
        for (int k = 0; k < 9; ++k) rows[k] = __builtin_amdgcn_readlane(myrow, k);
        const f32x2 st = *(const GAS f32x2*)(stats1 + (size_t)tok * 2);
        const size_t ro = (size_t)tok * D;
        f32x4 z[4][2]; float s = 0.f;
#pragma unroll
        for (int j = 0; j < 4; ++j) { const int c = 512 * j + 8 * F.lane;
            const f32x4 ha = *(const GAS f32x4*)(hbuf + ro + c), hb = *(const GAS f32x4*)(hbuf + ro + c + 4);
            const f32x4 ga = *(const f32x4*)(g0 + c), gb = *(const f32x4*)(g0 + c + 4), ba = *(const f32x4*)(b0 + c), bb = *(const f32x4*)(b0 + c + 4);
            f32x4 za = ((ha - st.x) * st.y * ga + ba) * DN_ALPHA, zb = ((hb - st.x) * st.y * gb + bb) * DN_ALPHA;
#pragma unroll
            for (int k = 0; k < 9; ++k) { const v4u y = *(const GAS v4u*)(Y + (size_t)rows[k] * D + c);
                za += (f32x4){bflo(y.x), bfhi(y.x), bflo(y.y), bfhi(y.y)}; zb += (f32x4){bflo(y.z), bfhi(y.z), bflo(y.w), bfhi(y.w)}; }
            z[j][0] = za; z[j][1] = zb; s += (za.x + za.y) + (za.z + za.w) + (zb.x + zb.y) + (zb.z + zb.w); }
        const float mean = wave_sum(s) * (1.0f / D); float q = 0.f;
#pragma unroll
        for (int j = 0; j < 4; ++j)
#pragma unroll
            for (int h = 0; h < 2; ++h) { z[j][h] = z[j][h] - mean; q += (z[j][h].x * z[j][h].x + z[j][h].y * z[j][h].y) + (z[j][h].z * z[j][h].z + z[j][h].w * z[j][h].w); }
        const float rstd = 1.0f / sqrtf(wave_sum(q) * (1.0f / D) + LN_EPS);
        float* dst = (layer == 0) ? hbuf : AR.out;
#pragma unroll
        for (int j = 0; j < 4; ++j) { const int c = 512 * j + 8 * F.lane;
            const f32x4 ga = *(const f32x4*)(g1 + c), gb = *(const f32x4*)(g1 + c + 4), ba = *(const f32x4*)(b1 + c), bb = *(const f32x4*)(b1 + c + 4);
            const f32x4 oa = z[j][0] * rstd * ga + ba, ob = z[j][1] * rstd * gb + bb;
            *(GAS f32x4*)(dst + ro + c) = oa; *(GAS f32x4*)(dst + ro + c + 4) = ob;
            if (layer == 0) { v4u o; o.x = pk2(oa.x, oa.y); o.y = pk2(oa.z, oa.w); o.z = pk2(ob.x, ob.y); o.w = pk2(ob.z, ob.w); *(GAS v4u*)(xa + ro + c) = o; } }
    }
}

#define IN(k) (lo <= (k) && (k) < hi)
#define SEAM(k) do { if (IN(k) && IN((k) + 1)) xcd_barrier(bar); } while (0)
template <int LAYER>
__device__ __forceinline__ void moe_block(Frame& F, const Args& args, const XcdBarrier& bar, const int lo, const int hi) {
    constexpr int pb = 1 + 7 * LAYER;
    LAS unsigned char* ring = F.lds + RING_OFF;
    const int cidx = (int)blockIdx.x;
    if (EN(7) && IN(pb + 3)) { moe_route(F, args, LAYER); } SEAM(pb + 3);
    if (EN(8) && IN(pb + 4)) {
        moe_tables(F, LAYER);
        MoeOrder<true> S; S.init(F.lds, 4, F.G, cidx);
        S.prepare((const int*)(F.ws + WS_STOK), (const float*)(F.ws + WS_SW), D * 2, F.tid);
        pg8::Gemm g{(const bf16*)(F.ws + WS_XA), (const bf16*)(F.ws + WS_WGU) + (size_t)LAYER * NE1 * 1024 * 2048, D};
        pg8::EpiSwiGLU E{(bf16*)(F.ws + WS_H), EFF, ROWW_OFF};
        pg8::gemm_phase<pg8::EpiSwiGLU, MoeOrder<true>>(ring, F.lds, g, S, E);
    } SEAM(pb + 4);
    if (EN(9) && IN(pb + 5)) {
        moe_tables(F, LAYER);
        MoeOrder<false> S; S.init(F.lds, 8, F.G, cidx);
        pg8::Gemm g{(const bf16*)(F.ws + WS_H), (const bf16*)(F.ws + WS_WD) + (size_t)LAYER * NE1 * 2048 * 512, EFF};
        pg8::EpiBf16<0> E{(bf16*)(F.ws + WS_Y), D, nullptr, 0, 1.f};
        pg8::gemm_phase<pg8::EpiBf16<0>, MoeOrder<false>>(ring, F.lds, g, S, E);
    } SEAM(pb + 5);
    if (EN(10) && IN(pb + 6)) { moe_tables(F, LAYER); moe_combine(F, args, LAYER); }
    if (LAYER == 0) SEAM(pb + 6);
}

__global__ void __launch_bounds__(NWAVES * 64, 2) fwd(Args args) {
    extern __shared__ __attribute__((aligned(16))) unsigned char lds[];
    Frame F;
    F.lds = (LAS unsigned char*)lds;
    F.MISC = (volatile LAS unsigned*)(F.lds + MISC_OFF);
    F.tid = threadIdx.x; F.lane = F.tid & 63; F.wave = __builtin_amdgcn_readfirstlane(F.tid >> 6);
    F.G = gridDim.x; { const int bx = blockIdx.x; F.vcu = (F.G % 8 == 0) ? (bx % 8) * (F.G / 8) + bx / 8 : bx; }
    F.ws = args.ws; F.ctl = (gu32*)(args.ws + WS_CTL);
    const Args& AR = args;
    if (F.tid < 64) F.MISC[F.tid] = 0u;
    __syncthreads();
    const int lo = args.ph_lo, hi = args.ph_hi;
    XcdBarrier bar; bar.bar = (unsigned*)(F.ctl + CW_BAR); bar.x = 0; bar.st = nullptr;
    if (hi - lo > 1) bar = xcd_barrier_post((unsigned*)(F.ctl + CW_BAR), F.MISC + 8);
    LAS unsigned char* ring = F.lds + RING_OFF;
    const int cidx = (int)blockIdx.x;

    if (EN(0) && IN(0)) { p0_prologue(F, args); } SEAM(0);

    if (EN(1) && IN(1)) {
        { pg8::Gemm g{(const bf16*)(F.ws + WS_XA), (const bf16*)(F.ws + WS_WIN), D}; pg8::StaticOrder S; S.init(T / 256, AH / 256, F.G, cidx);
          pg8::EpiBf16<1> E{(bf16*)(F.ws + WS_U), AH, AR.in[I_ABIN], 0, 1.f};
          pg8::gemm_phase<pg8::EpiBf16<1>, pg8::StaticOrder>(ring, F.lds, g, S, E); }
        { pg8::Gemm g{(const bf16*)(F.ws + WS_WIN) + (size_t)AH * D, (const bf16*)(F.ws + WS_XA), D}; pg8::StaticOrder S; S.init(AH / 256, T / 256, F.G, cidx);
          pg8::EpiRowBias<true, true> E{(bf16*)(F.ws + WS_VT), T, AR.in[I_ABIN] + AH, (float*)(F.ws + WS_VST), T};
          pg8::gemm_phase<pg8::EpiRowBias<true, true>, pg8::StaticOrder>(ring, F.lds, g, S, E); }
    } SEAM(1);
    if (EN(2) && IN(2)) { p2_sgu(F, args); } SEAM(2);
    if (EN(3) && IN(3)) {
        pg8::Gemm g{(const bf16*)(F.ws + WS_GT), (const bf16*)(F.ws + WS_WOUT), AH}; pg8::StaticOrder S; S.init(T / 256, D / 256, F.G, cidx);
        pg8::EpiResF32 E{AR.in[I_X], (float*)(F.ws + WS_HBUF), D, nullptr, DN_ALPHA};
        pg8::gemm_phase<pg8::EpiResF32, pg8::StaticOrder>(ring, F.lds, g, S, E);
    } SEAM(3);
    moe_block<0>(F, args, bar, lo, hi);

    if (EN(4) && IN(8)) {
        { pg8::Gemm g{(const bf16*)(F.ws + WS_XA), (const bf16*)(F.ws + WS_WQKV), D}; pg8::StaticOrder S; S.init(T / 256, QKW / 256, F.G, cidx);
          pg8::EpiBf16<0> E{(bf16*)(F.ws + WS_U), QKW, AR.in[I_BBQKV], 8, 0.125f};
          pg8::gemm_phase<pg8::EpiBf16<0>, pg8::StaticOrder>(ring, F.lds, g, S, E); }
        { pg8::Gemm g{(const bf16*)(F.ws + WS_WQKV) + (size_t)QKW * D, (const bf16*)(F.ws + WS_XA), D}; pg8::StaticOrder S; S.init(1, T / 256, F.G, (cidx + F.G - 64) % F.G);
          pg8::EpiRowBias<false, false> E{(bf16*)(F.ws + WS_VT), T, AR.in[I_BBQKV] + QKW, nullptr, T};
          pg8::gemm_phase<pg8::EpiRowBias<false, false>, pg8::StaticOrder>(ring, F.lds, g, S, E); }
    } SEAM(8);
    if (EN(5) && IN(9)) { attn_phase(F, args); } SEAM(9);
    if (EN(6) && IN(10)) {
        pg8::Gemm g{(const bf16*)(F.ws + WS_GT), (const bf16*)(F.ws + WS_WO), D}; pg8::StaticOrder S; S.init(T / 256, D / 256, F.G, cidx);
        pg8::EpiResF32 E{(const float*)(F.ws + WS_HBUF), (float*)(F.ws + WS_HBUF), D, AR.in[I_BBO], DN_ALPHA};
        pg8::gemm_phase<pg8::EpiResF32, pg8::StaticOrder>(ring, F.lds, g, S, E);
    } SEAM(10);
    moe_block<1>(F, args, bar, lo, hi);
}
#undef IN
#undef SEAM

extern "C" void kernel_launch(void* const* d_in, const int* in_sizes, int n_in, void* d_out, int out_size, void* d_ws, size_t ws_size, hipStream_t stream) {
    static int grid = 0;
    if (grid == 0) {
        if (n_in != 23 || out_size != T * D || ws_size < WS_END) { fprintf(stderr, "kernel_launch: unexpected problem (n_in %d out %d ws %zu, need %zu)\n", n_in, out_size, ws_size, (size_t)WS_END); grid = -1; return; }
        int dev = 0, cus = 0, per_cu = 0;
        if (hipGetDevice(&dev) != hipSuccess || hipDeviceGetAttribute(&cus, hipDeviceAttributeMultiprocessorCount, dev) != hipSuccess) { grid = -1; return; }
        if (hipFuncSetAttribute((const void*)fwd, hipFuncAttributeMaxDynamicSharedMemorySize, LDS_BYTES) != hipSuccess) { fprintf(stderr, "kernel_launch: hipFuncSetAttribute failed\n"); grid = -1; return; }
        if (hipOccupancyMaxActiveBlocksPerMultiprocessor(&per_cu, (const void*)fwd, NWAVES * 64, LDS_BYTES) != hipSuccess || per_cu < 1)
            fprintf(stderr, "kernel_launch: occupancy query reports %d workgroups per CU\n", per_cu);
        (void)hipGetLastError();
        grid = cus;
    }
    if (grid < 0) return;
    if (hipMemsetAsync((char*)d_ws + WS_CTL, 0, CTL_ZERO_BYTES, stream) != hipSuccess) { fprintf(stderr, "kernel_launch: memset failed\n"); return; }
    Args a{};
    for (int i = 0; i < 23; ++i) a.in[i] = (const float*)d_in[i];
    a.out = (float*)d_out; a.ws = (unsigned char*)d_ws;
    constexpr int NL = MK_N_LAUNCHES;
    for (int li = 0; li < NL; ++li) {
        a.ph_lo = (NL == 1) ? 0 : li; a.ph_hi = (NL == 1) ? N_PHASES : li + 1;
        hipLaunchKernelGGL(fwd, dim3(grid), dim3(NWAVES * 64), LDS_BYTES, stream, a);
        const hipError_t le = hipPeekAtLastError();
        if (le != hipSuccess) { fprintf(stderr, "kernel_launch: launch %d failed: %s\n", li, hipGetErrorName(le)); break; }
    }
}
```

```cpp
#include <hip/hip_runtime.h>
#include <cstdio>
#include <cstdint>

#ifndef PH_MASK
#define PH_MASK 0x7ff
#endif
#define EN(k) (((PH_MASK) >> (k)) & 1)
#ifndef MK_N_LAUNCHES
#define MK_N_LAUNCHES 1
#endif

namespace pg8 {
#define PG8_LAS __attribute__((address_space(3)))
typedef unsigned short bf16_t;
typedef short bf16x8 __attribute__((ext_vector_type(8)));
typedef float f32x4 __attribute__((ext_vector_type(4)));
typedef float f32x2 __attribute__((ext_vector_type(2)));
typedef unsigned u32x4 __attribute__((ext_vector_type(4)));
typedef unsigned u32x2 __attribute__((ext_vector_type(2)));
constexpr int BM = 256, BK = 64, HALF = 128, HTB = HALF * BK * 2, STAGE_BYTES = 8 * HTB, NXCD = 8, WGM = 8;

__host__ __device__ __forceinline__ int lds_byte(int r, int c) { const int st = (r >> 4) * 2 + (c >> 5), rr = r & 15, cc = c & 31, ob = rr * 64 + cc * 2; return st * 1024 + (ob ^ (((ob >> 9) & 1) << 5)); }
__host__ __device__ __forceinline__ void stage_rc(int b, int& R, int& C) { const int st = b / 1024, sb = b % 1024, swz = sb ^ (((sb >> 9) & 1) << 5); R = (st >> 1) * 16 + swz / 64; C = (st & 1) * 32 + (swz % 64) / 2; }
__host__ __device__ __forceinline__ int perm32(int rho) { const int n = rho >> 4, i = rho & 15; return 8 * (i >> 2) + 4 * n + (i & 3); }

struct Unit { int pm, pn, pb, ord; };
struct Gemm { const bf16_t* A; const bf16_t* Bt; int K; };

struct StaticOrder {
    static constexpr bool GATHER = false;
    int nM, nN, nwg, G, c;
    __device__ __forceinline__ void init(int nM_, int nN_, int G_, int c_) { nM = nM_; nN = nN_; nwg = nM * nN; G = G_; c = c_; }
    __device__ __forceinline__ bool map(int i, int& pm, int& pn) const {
        const long L = (long)i * G + c; if (L >= nwg) return false;
        int wgid = (int)L; { const int q = nwg / NXCD, r = nwg % NXCD, xcd = wgid % NXCD, off = wgid / NXCD; wgid = (xcd < r ? xcd * (q + 1) : r * (q + 1) + (xcd - r) * q) + off; }
        const int nig = WGM * nN, gid = wgid / nig, fm = gid * WGM, gsz = (nM - fm) < WGM ? (nM - fm) : WGM;
        pm = fm + ((wgid % nig) % gsz); pn = (wgid % nig) / gsz; return true;
    }
    __device__ __forceinline__ bool next(int i, Unit& u) const { if (!map(i, u.pm, u.pn)) return false; u.pb = u.pn; u.ord = i; return true; }
    __device__ __forceinline__ unsigned rowoff(int, int) const { return 0u; }
};

__device__ __forceinline__ unsigned cvt_pk_bf16(float lo, float hi) { unsigned r; asm volatile("v_cvt_pk_bf16_f32 %0, %1, %2" : "=v"(r) : "v"(lo), "v"(hi)); return r; }
__device__ __forceinline__ f32x2 gelu_pk(f32x2 v) {
    const f32x2 av = __builtin_elementwise_abs(v), d = av * 0.2316418882f + 1.0f;
    f32x2 t; t.x = __builtin_amdgcn_rcpf(d.x); t.y = __builtin_amdgcn_rcpf(d.y);
    f32x2 q = t * 0.5307027145f + (-0.7265760135f); q = q * t + 0.7107068705f; q = q * t + (-0.142248368f); q = q * t + 0.127414796f; q = q * t;
    const f32x2 s = (v * v) * (-0.72134752044f);
    f32x2 e; e.x = __builtin_amdgcn_exp2f(s.x); e.y = __builtin_amdgcn_exp2f(s.y);
    const f32x2 m = v * (q * e), r = v - m;
    f32x2 o; o.x = v.x < 0.f ? m.x : r.x; o.y = v.y < 0.f ? m.y : r.y; return o;
}
template <int CTRL> __device__ __forceinline__ float dppf(float v) { return __builtin_bit_cast(float, __builtin_amdgcn_update_dpp(0, __builtin_bit_cast(int, v), CTRL, 0xf, 0xf, false)); }
__device__ __forceinline__ float row16_sum(float v) { v += dppf<0xB1>(v); v += dppf<0x4E>(v); v += dppf<0x141>(v); v += dppf<0x128>(v); return v; }

template <int ACT> struct EpiBf16 {
    static constexpr bool PERM = true;
    bf16_t* O; int ldc; const float* bias; int nscale; float scale0;
    __device__ __forceinline__ void operator()(const f32x4 (&acc)[2][2][4][2], const Unit& u, int wr, int wc, int fr, int fq, PG8_LAS unsigned char*) const {
        const int row0 = u.pm * BM + wr * 64 + fr; const int col0 = u.pn * BM + wc * 32 + 8 * fq;
        const float sc = (u.pn < nscale) ? scale0 : 1.f;
        f32x4 bv[2][2];
#pragma unroll
        for (int bj = 0; bj < 2; ++bj)
#pragma unroll
            for (int n = 0; n < 2; ++n) bv[bj][n] = bias ? *(const f32x4*)(bias + col0 + bj * HALF + 4 * n) : (f32x4){0.f, 0.f, 0.f, 0.f};
#pragma unroll
        for (int ai = 0; ai < 2; ++ai)
#pragma unroll
            for (int m = 0; m < 4; ++m) { bf16_t* rowp = O + (size_t)(row0 + ai * HALF + m * 16) * ldc + col0;
#pragma unroll
                for (int bj = 0; bj < 2; ++bj) { f32x4 v0 = acc[ai][bj][m][0] + bv[bj][0], v1 = acc[ai][bj][m][1] + bv[bj][1];
                    if (ACT == 1) { f32x2 a = gelu_pk((f32x2){v0[0], v0[1]}), b = gelu_pk((f32x2){v0[2], v0[3]}), c = gelu_pk((f32x2){v1[0], v1[1]}), d = gelu_pk((f32x2){v1[2], v1[3]});
                        v0 = (f32x4){a.x, a.y, b.x, b.y}; v1 = (f32x4){c.x, c.y, d.x, d.y}; }
                    v0 = v0 * sc; v1 = v1 * sc; u32x4 w; w.x = cvt_pk_bf16(v0[0], v0[1]); w.y = cvt_pk_bf16(v0[2], v0[3]); w.z = cvt_pk_bf16(v1[0], v1[1]); w.w = cvt_pk_bf16(v1[2], v1[3]);
                    *(u32x4*)(rowp + bj * HALF) = w; } }
    }
};
template <bool GELU, bool STATS> struct EpiRowBias {
    static constexpr bool PERM = true;
    bf16_t* O; int ldc; const float* rbias; float* stat; int T;
    __device__ __forceinline__ void operator()(const f32x4 (&acc)[2][2][4][2], const Unit& u, int wr, int wc, int fr, int fq, PG8_LAS unsigned char*) const {
        const int row0 = u.pm * BM + wr * 64 + fr; const int col0 = u.pn * BM + wc * 32 + 8 * fq;
#pragma unroll
        for (int bj = 0; bj < 2; ++bj) {
            f32x4 s1[2], s2[2];
#pragma unroll
            for (int n = 0; n < 2; ++n) { s1[n] = (f32x4){0.f, 0.f, 0.f, 0.f}; s2[n] = (f32x4){0.f, 0.f, 0.f, 0.f}; }
#pragma unroll
            for (int ai = 0; ai < 2; ++ai)
#pragma unroll
                for (int m = 0; m < 4; ++m) { const int row = row0 + ai * HALF + m * 16; const float rb = rbias[row];
                    f32x4 v0 = acc[ai][bj][m][0] + rb, v1 = acc[ai][bj][m][1] + rb;
                    if (GELU) { f32x2 a = gelu_pk((f32x2){v0[0], v0[1]}), b = gelu_pk((f32x2){v0[2], v0[3]}), c = gelu_pk((f32x2){v1[0], v1[1]}), d = gelu_pk((f32x2){v1[2], v1[3]});
                        v0 = (f32x4){a.x, a.y, b.x, b.y}; v1 = (f32x4){c.x, c.y, d.x, d.y}; }
                    if (STATS) { s1[0] += v0; s1[1] += v1; s2[0] += v0 * v0; s2[1] += v1 * v1; }
                    u32x4 w; w.x = cvt_pk_bf16(v0[0], v0[1]); w.y = cvt_pk_bf16(v0[2], v0[3]); w.z = cvt_pk_bf16(v1[0], v1[1]); w.w = cvt_pk_bf16(v1[2], v1[3]);
                    *(u32x4*)(O + (size_t)row * ldc + col0 + bj * HALF) = w; }
            if (STATS) {
#pragma unroll
                for (int n = 0; n < 2; ++n)
#pragma unroll
                    for (int j = 0; j < 4; ++j) { s1[n][j] = row16_sum(s1[n][j]); s2[n][j] = row16_sum(s2[n][j]); }
                if (fr == 0) { const int P = u.pm * 2 + wr; float* sp = stat + ((size_t)P * T + col0 + bj * HALF) * 2;
#pragma unroll
                    for (int n = 0; n < 2; ++n) { *(f32x4*)(sp + 8 * n) = (f32x4){s1[n][0], s2[n][0], s1[n][1], s2[n][1]}; *(f32x4*)(sp + 8 * n + 4) = (f32x4){s1[n][2], s2[n][2], s1[n][3], s2[n][3]}; } }
            }
        }
    }
};
struct EpiResF32 {
    static constexpr bool PERM = false;
    const float* res; float* out; int ldc; const float* bias; float alpha;
    __device__ __forceinline__ void operator()(const f32x4 (&acc)[2][2][4][2], const Unit& u, int wr, int wc, int fr, int fq, PG8_LAS unsigned char*) const {
        const int row0 = u.pm * BM + wr * 64 + fr, col0 = u.pn * BM + wc * 32 + 4 * fq;
        f32x4 bv[2][2];
#pragma unroll
        for (int bj = 0; bj < 2; ++bj)
#pragma unroll
            for (int n = 0; n < 2; ++n) bv[bj][n] = bias ? *(const f32x4*)(bias + col0 + bj * HALF + n * 16) : (f32x4){0.f, 0.f, 0.f, 0.f};
#pragma unroll
        for (int ai = 0; ai < 2; ++ai)
#pragma unroll
            for (int m = 0; m < 4; ++m) { const size_t off = (size_t)(row0 + ai * HALF + m * 16) * ldc + col0;
                f32x4 rv[2][2];
#pragma unroll
                for (int bj = 0; bj < 2; ++bj)
#pragma unroll
                    for (int n = 0; n < 2; ++n) rv[bj][n] = *(const f32x4*)(res + off + bj * HALF + n * 16);
#pragma unroll
                for (int bj = 0; bj < 2; ++bj)
#pragma unroll
                    for (int n = 0; n < 2; ++n) *(f32x4*)(out + off + bj * HALF + n * 16) = rv[bj][n] * alpha + acc[ai][bj][m][n] + bv[bj][n];
                if (m & 1) asm volatile("" ::: "memory"); }
    }
};
struct EpiSwiGLU {
    static constexpr bool PERM = true;
    bf16_t* H; int ldc; int roww_off;
    __device__ __forceinline__ void operator()(const f32x4 (&acc)[2][2][4][2], const Unit& u, int wr, int wc, int fr, int fq, PG8_LAS unsigned char* ldsbase) const {
        const int row0 = u.pm * BM + wr * 64 + fr; const int col0 = u.pn * HALF + wc * 32 + 8 * fq;
        const PG8_LAS float* rw = (const PG8_LAS float*)(ldsbase + roww_off) + u.ord * 256 + wr * 64 + fr;
#pragma unroll
        for (int ai = 0; ai < 2; ++ai)
#pragma unroll
            for (int m = 0; m < 4; ++m) { const float w = rw[ai * HALF + m * 16]; bf16_t* rowp = H + (size_t)(row0 + ai * HALF + m * 16) * ldc + col0;
                f32x4 o[2];
#pragma unroll
                for (int n = 0; n < 2; ++n) { const f32x4 g = acc[ai][0][m][n], up = acc[ai][1][m][n];
#pragma unroll
                    for (int j = 0; j < 4; ++j) { const float sg = g[j] * __builtin_amdgcn_rcpf(1.0f + __builtin_amdgcn_exp2f(-1.44269504089f * g[j])); o[n][j] = sg * up[j] * w; } }
                u32x4 pk; pk.x = cvt_pk_bf16(o[0][0], o[0][1]); pk.y = cvt_pk_bf16(o[0][2], o[0][3]); pk.z = cvt_pk_bf16(o[1][0], o[1][1]); pk.w = cvt_pk_bf16(o[1][2], o[1][3]);
                *(u32x4*)rowp = pk; }
    }
};

template <class Epi, class Sched, bool ALIGN_EPI = true>
__device__ __forceinline__ void gemm_phase(PG8_LAS unsigned char* lds, PG8_LAS unsigned char* ldsbase, const Gemm g, const Sched& S, const Epi& E) {
    constexpr bool GATHER = Sched::GATHER;
    const int tid = threadIdx.x, wid = __builtin_amdgcn_readfirstlane(tid >> 6), lane = tid & 63, wr = wid >> 2, wc = wid & 3, fr = lane & 15, fq = lane >> 4;
    const int K = g.K, nt = K / BK;
    unsigned voffA[2], voffB[2];
#pragma unroll
    for (int i = 0; i < 2; ++i) { int R, C; stage_rc(tid * 16 + i * 8192, R, C); const int Rb = Epi::PERM ? ((R & ~31) + perm32(R & 31)) : R;
        voffA[i] = (unsigned)(R * K + C) * 2u; voffB[i] = (unsigned)(Rb * K + C) * 2u; }
    unsigned gA[2][2];
#define PG8_LOAD_GA(ordv) do { _Pragma("unroll") for (int _h = 0; _h < 2; ++_h) _Pragma("unroll") for (int _i = 0; _i < 2; ++_i) { int _R, _C; stage_rc(tid * 16 + _i * 8192, _R, _C); \
        gA[_h][_i] = S.rowoff((ordv), _h * HALF + _R) + (unsigned)_C * 2u; } } while (0)
    const size_t kstep = (size_t)(BK * 2);
    const size_t hstep = (size_t)HALF * K * 2;
    const size_t tstep = 2 * hstep;
    const unsigned ldsw = (unsigned)wid * 1024u;
    const int aoff = lds_byte(wr * 64 + fr, fq * 8), boff = lds_byte(wc * 32 + fr, fq * 8);
#define PG8_SA(b, h) (((b) * 2 + (h)) * HTB)
#define PG8_SB(b, h) ((4 + (b) * 2 + (h)) * HTB)
#define PG8_STAGE(bufoff, gbase, voff) do { _Pragma("unroll") for (int _i = 0; _i < 2; ++_i) \
        __builtin_amdgcn_global_load_lds((const unsigned*)((const char*)(gbase) + (voff)[_i]), (PG8_LAS unsigned*)(lds + (bufoff) + ldsw + _i * 8192), 16, 0, 0); } while (0)
#define PG8_STAGE_A(b, h, kptr) do { if constexpr (GATHER) { PG8_STAGE(PG8_SA(b, h), kptr, gA[h]); } else { PG8_STAGE(PG8_SA(b, h), (kptr) + (h) * hstep, voffA); } } while (0)
#define PG8_LDA(dst, b, h) do { _Pragma("unroll") for (int m = 0; m < 4; ++m) _Pragma("unroll") for (int k = 0; k < 2; ++k) dst[m][k] = *(const PG8_LAS bf16x8*)(lds + PG8_SA(b, h) + aoff + m * 2048 + k * 1024); } while (0)
#define PG8_LDB(dst, b, h) do { _Pragma("unroll") for (int n = 0; n < 2; ++n) _Pragma("unroll") for (int k = 0; k < 2; ++k) dst[n][k] = *(const PG8_LAS bf16x8*)(lds + PG8_SB(b, h) + boff + n * 2048 + k * 1024); } while (0)
#define PG8_MMA(ai, bj, At, Bt) do { __builtin_amdgcn_s_setprio(1); _Pragma("unroll") for (int m = 0; m < 4; ++m) _Pragma("unroll") for (int n = 0; n < 2; ++n) _Pragma("unroll") for (int k = 0; k < 2; ++k) \
        acc[ai][bj][m][n] = __builtin_amdgcn_mfma_f32_16x16x32_bf16(Bt[n][k], At[m][k], acc[ai][bj][m][n], 0, 0, 0); __builtin_amdgcn_s_setprio(0); } while (0)
#define PG8_WAIT_V(n) asm volatile("s_waitcnt vmcnt(" #n ")" ::: "memory")
#define PG8_WAIT_L(n) asm volatile("s_waitcnt lgkmcnt(" #n ")" ::: "memory")
#define PG8_BAR __builtin_amdgcn_s_barrier()
#define PG8_SCHED __builtin_amdgcn_sched_barrier(0)
    Unit cur, nxt; int ui = 0;
    if (!S.next(0, cur)) return;
    f32x4 acc[2][2][4][2];
#pragma unroll
    for (int a = 0; a < 2; ++a)
#pragma unroll
        for (int b = 0; b < 2; ++b)
#pragma unroll
            for (int m = 0; m < 4; ++m)
#pragma unroll
                for (int n = 0; n < 2; ++n) acc[a][b][m][n] = (f32x4){0.f, 0.f, 0.f, 0.f};
    bf16x8 At[4][2], B0[2][2], B1[2][2];
    const char* cA = GATHER ? (const char*)g.A : (const char*)g.A + (size_t)cur.pm * tstep; const char* cB = (const char*)g.Bt + (size_t)cur.pb * tstep;
    if constexpr (GATHER) { PG8_LOAD_GA(cur.ord); }
    PG8_STAGE(PG8_SB(0, 0), cB, voffB); PG8_STAGE(PG8_SB(0, 1), cB + hstep, voffB); PG8_STAGE_A(0, 0, cA); PG8_STAGE_A(0, 1, cA);
    if (wr == 1) PG8_BAR;
    PG8_WAIT_V(2); PG8_BAR;
    PG8_STAGE(PG8_SB(1, 0), cB + kstep, voffB); PG8_STAGE_A(1, 0, cA + kstep); PG8_STAGE(PG8_SB(1, 1), cB + hstep + kstep, voffB);
    PG8_WAIT_V(6); PG8_BAR;
    for (;;) {
        const bool has_next = S.next(ui + 1, nxt);
        const char* nA = GATHER ? (const char*)g.A : (has_next ? (const char*)g.A + (size_t)nxt.pm * tstep : cA); const char* nB = has_next ? (const char*)g.Bt + (size_t)nxt.pb * tstep : cB;
        for (int t = 0; t < nt; t += 2) {
            const bool last = (t == nt - 2);
            const char* a1 = cA + (size_t)(t + 1) * kstep;
            const char* a2 = last ? nA : cA + (size_t)(t + 2) * kstep; const char* b2 = last ? nB : cB + (size_t)(t + 2) * kstep;
            const char* a3 = a2 + kstep; const char* b3 = b2 + kstep;
            PG8_LDB(B0, 0, 0); PG8_LDB(B1, 0, 1); PG8_SCHED; PG8_LDA(At, 0, 0); PG8_STAGE_A(1, 1, a1);
            PG8_WAIT_V(8); PG8_WAIT_L(0); PG8_BAR; PG8_MMA(0, 0, At, B0); PG8_MMA(0, 1, At, B1); PG8_BAR; PG8_SCHED;
            if constexpr (GATHER) { if (last && has_next) { PG8_LOAD_GA(nxt.ord); } }
            PG8_LDA(At, 0, 1); PG8_STAGE(PG8_SB(0, 0), b2, voffB); PG8_STAGE(PG8_SB(0, 1), b2 + hstep, voffB); PG8_STAGE_A(0, 0, a2);
            PG8_WAIT_V(8); PG8_WAIT_L(0); PG8_BAR; PG8_MMA(1, 0, At, B0); PG8_MMA(1, 1, At, B1); PG8_BAR; PG8_SCHED;
            PG8_LDB(B0, 1, 0); PG8_LDB(B1, 1, 1); PG8_SCHED; PG8_LDA(At, 1, 0); PG8_STAGE_A(0, 1, a2);
            PG8_WAIT_V(8); PG8_WAIT_L(0); PG8_BAR; PG8_MMA(0, 0, At, B0); PG8_MMA(0, 1, At, B1); PG8_BAR; PG8_SCHED;
            PG8_LDA(At, 1, 1); PG8_STAGE(PG8_SB(1, 0), b3, voffB); PG8_STAGE(PG8_SB(1, 1), b3 + hstep, voffB); PG8_STAGE_A(1, 0, a3);
            PG8_WAIT_V(8); PG8_WAIT_L(0); PG8_BAR; PG8_MMA(1, 0, At, B0); PG8_MMA(1, 1, At, B1); PG8_BAR; PG8_SCHED;
        }
        if constexpr (ALIGN_EPI) { if (wr == 0) PG8_BAR; }
        E(acc, cur, wr, wc, fr, fq, ldsbase);
        if (!has_next) break;
#pragma unroll
        for (int a = 0; a < 2; ++a)
#pragma unroll
            for (int b = 0; b < 2; ++b)
#pragma unroll
                for (int m = 0; m < 4; ++m)
#pragma unroll
                    for (int n = 0; n < 2; ++n) acc[a][b][m][n] = (f32x4){0.f, 0.f, 0.f, 0.f};
        cur = nxt; cA = nA; cB = nB; ++ui;
        if constexpr (ALIGN_EPI) { if (wr == 1) PG8_BAR; }
    }
    PG8_WAIT_V(0);
    if constexpr (!ALIGN_EPI) { if (wr == 0) PG8_BAR; }
    PG8_BAR;
#undef PG8_SA
#undef PG8_SB
#undef PG8_STAGE
#undef PG8_STAGE_A
#undef PG8_LOAD_GA
#undef PG8_LDA
#undef PG8_LDB
#undef PG8_MMA
#undef PG8_WAIT_V
#undef PG8_WAIT_L
#undef PG8_BAR
#undef PG8_SCHED
}
}

constexpr int NWAVES = 8;
constexpr int T = 16384, D = 2048, SEQ = 2048, NB_PER_SEQ = 16;
constexpr int AH = 2048, NGRP = 16;
constexpr int NQH = 32, NKVH = 4, HD = 64, QKW = 2304, QKVW = 2560;
constexpr int NE = 64, NE1 = 65, TOPK = 8, EFF = 512;
constexpr int CAP = 16384;
constexpr int MAXRT = 704;
constexpr int NU_MAX = 12;
constexpr float LN_EPS = 1e-5f;
constexpr float DN_ALPHA = 1.41421356237309515f;
constexpr int N_PHASES = 15;

constexpr size_t MiB = 1u << 20;
constexpr size_t WS_CTL = 0, CTL_ZERO_BYTES = 1 * MiB;
constexpr size_t WS_WIN = 1 * MiB;
constexpr size_t WS_WOUT = WS_WIN + 16 * MiB;
constexpr size_t WS_WQKV = WS_WOUT + 8 * MiB;
constexpr size_t WS_WO = WS_WQKV + 10 * MiB;
constexpr size_t WS_WGU = WS_WO + 8 * MiB;
constexpr size_t WS_WD = WS_WGU + 520 * MiB;
constexpr size_t WS_RT = WS_WD + 260 * MiB;
constexpr size_t WS_HBUF = WS_RT + 2 * MiB;
constexpr size_t WS_XA = WS_HBUF + 128 * MiB;
constexpr size_t WS_U = WS_XA + 64 * MiB;
constexpr size_t WS_VT = WS_U + 72 * MiB;
constexpr size_t WS_GT = WS_VT + 64 * MiB;
constexpr size_t WS_H = WS_GT + 64 * MiB;
constexpr size_t WS_Y = WS_H + 160 * MiB;
constexpr size_t WS_STOK = WS_Y + 640 * MiB;
constexpr size_t WS_SW = WS_STOK + 4 * MiB;
constexpr size_t WS_TSLOT = WS_SW + 4 * MiB;
constexpr size_t WS_ST1 = WS_TSLOT + 1 * MiB;
constexpr size_t WS_VST = WS_ST1 + 1 * MiB;
constexpr size_t WS_END = WS_VST + 2 * MiB;
static_assert(WS_END <= (size_t)2048 * MiB, "d_ws map must fit 2 GiB");
constexpr int CW_TMO = 0, CW_CODE = 1;
constexpr int CW_CNT = 1024;
constexpr int CW_BAR = 4096;
constexpr int RING_OFF = 0, RING_BYTES = 131072;
constexpr int TAB_OFF = 131072;
constexpr int TAB_TILE_E = TAB_OFF, TAB_RTS = TAB_OFF + MAXRT * 4, TAB_CNT = TAB_RTS + 66 * 4, TAB_PST = TAB_CNT + 66 * 4, TAB_END = TAB_PST + 66 * 4;
constexpr int ROWTAB_OFF = 135168;
constexpr int ROWW_OFF = ROWTAB_OFF + NU_MAX * 1024;
constexpr int MISC_OFF = ROWW_OFF + NU_MAX * 1024;
constexpr int LDS_BYTES = 163840;
static_assert(TAB_END <= ROWTAB_OFF && MISC_OFF + 256 <= LDS_BYTES, "LDS map");

#define GAS __attribute__((address_space(1)))
#define LAS __attribute__((address_space(3)))
typedef unsigned short bf16;
typedef unsigned v4u __attribute__((ext_vector_type(4)));
typedef unsigned v2u __attribute__((ext_vector_type(2)));
typedef float f32x4 __attribute__((ext_vector_type(4)));
typedef float f32x2 __attribute__((ext_vector_type(2)));
typedef short bf16x8 __attribute__((ext_vector_type(8)));
typedef GAS unsigned gu32;
#define RLX_AGENT __ATOMIC_RELAXED, __HIP_MEMORY_SCOPE_AGENT
#define LDS_WAIT() asm volatile("s_waitcnt lgkmcnt(0)" ::: "memory")
#define VM_WAIT() asm volatile("s_waitcnt vmcnt(0)" ::: "memory")
__device__ __forceinline__ unsigned f2bf(float f) { unsigned u = __builtin_bit_cast(unsigned, f); return (u + 0x7fffu + ((u >> 16) & 1u)) >> 16; }
__device__ __forceinline__ unsigned pk2(float lo, float hi) { return f2bf(lo) | (f2bf(hi) << 16); }
__device__ __forceinline__ float bflo(unsigned w) { return __builtin_bit_cast(float, w << 16); }
__device__ __forceinline__ float bfhi(unsigned w) { return __builtin_bit_cast(float, w & 0xffff0000u); }

#define XB_TMO      128
#define XB_XCNT(j)  (256  + 64 * (j))
#define XB_XSUB(j)  (1280 + 64 * (j))
#define XB_XGEN(j)  (2304 + 64 * (j))
#define XB_TOP      3328
#define XB_TOPGEN   3392
#define XCD_BAR_WORDS 3456
#define XB_SPIN_CAP (1u << 18)
__device__ __forceinline__ unsigned xb_ld(unsigned* p)              { return __hip_atomic_load(p, __ATOMIC_RELAXED, __HIP_MEMORY_SCOPE_AGENT); }
__device__ __forceinline__ unsigned xb_add(unsigned* p, unsigned v) { return __hip_atomic_fetch_add(p, v, __ATOMIC_RELAXED, __HIP_MEMORY_SCOPE_AGENT); }
__device__ __forceinline__ unsigned xb_xcc_id() { return (unsigned)__builtin_amdgcn_s_getreg((3 << 11) | 20) & 0xFu; }
#define XB_SPIN(cond, bar) do { unsigned _sp = 0; while (cond) { __builtin_amdgcn_s_sleep(1); \
    if ((++_sp & 255u) == 0u) { if (xb_ld(&(bar)[XB_TMO])) break; if (_sp > XB_SPIN_CAP) { atomicAdd(&(bar)[XB_TMO], 1u); break; } } } } while (0)
struct XcdBarrier { unsigned* bar; unsigned x; volatile LAS unsigned* st; };
__device__ __forceinline__ XcdBarrier xcd_barrier_post(unsigned* bar, volatile LAS unsigned* st) {
    XcdBarrier b; b.bar = bar; b.x = xb_xcc_id(); b.st = st;
    if (threadIdx.x == 0) (void)xb_add(&bar[XB_XCNT(b.x)], 1u);
    return b;
}
__device__ __forceinline__ void xcd_barrier_complete(unsigned* bar, unsigned x, unsigned& nloc, unsigned& nx) {
    const unsigned G = gridDim.x * gridDim.y * gridDim.z;
    unsigned sum, cnt, mine, sp = 0u;
    for (;;) {
        sum = 0u; cnt = 0u; mine = 0u;
#pragma unroll
        for (unsigned j = 0; j < 16; ++j) { const unsigned c = xb_ld(&bar[XB_XCNT(j)]); sum += c; cnt += (c > 0u) ? 1u : 0u; mine = (j == x) ? c : mine; }
        if (sum == G) break;
        __builtin_amdgcn_s_sleep(1);
        if ((++sp & 255u) == 0u) { if (xb_ld(&bar[XB_TMO])) break; if (sp > XB_SPIN_CAP) { atomicAdd(&bar[XB_TMO], 1u); break; } }
    }
    nloc = mine > 0u ? mine : 1u; nx = cnt > 0u ? cnt : 1u;
}
__device__ __forceinline__ void xcd_barrier(const XcdBarrier& b) {
    asm volatile("s_waitcnt vmcnt(0)" ::: "memory");
    __syncthreads();
    if (threadIdx.x == 0) {
        unsigned* bar = b.bar;
        __builtin_amdgcn_s_waitcnt(0);
        unsigned nloc = b.st[0], nx = b.st[1];
        if (nloc == 0u) { xcd_barrier_complete(bar, b.x, nloc, nx); b.st[0] = nloc; b.st[1] = nx; }
        const unsigned old = xb_add(&bar[XB_XSUB(b.x)], 1u);
        const unsigned gen = old / nloc;
        if (old + 1u == (gen + 1u) * nloc) {
            __builtin_amdgcn_fence(__ATOMIC_RELEASE, "agent");
            asm volatile("s_waitcnt vmcnt(0)" ::: "memory");
            const unsigned og = xb_add(&bar[XB_TOP], 1u);
            const unsigned tg = og / nx;
            if (og + 1u == (tg + 1u) * nx) xb_add(&bar[XB_TOPGEN], 1u);
            else XB_SPIN(xb_ld(&bar[XB_TOPGEN]) == tg, bar);
            __builtin_amdgcn_fence(__ATOMIC_ACQUIRE, "agent");
            xb_add(&bar[XB_XGEN(b.x)], 1u);
            asm volatile("s_waitcnt vmcnt(0)" ::: "memory");
        } else {
            XB_SPIN(xb_ld(&bar[XB_XGEN(b.x)]) == gen, bar);
            __builtin_amdgcn_fence(__ATOMIC_ACQUIRE, "agent");
            asm volatile("s_waitcnt vmcnt(0)" ::: "memory");
        }
    }
    __syncthreads();
}

struct Frame {
    LAS unsigned char* lds;
    volatile LAS unsigned* MISC;
    gu32* ctl;
    int tid, lane, wave;
    int vcu, G;
    unsigned char* ws;
};
struct Args { const float* in[23]; float* out; unsigned char* ws; int ph_lo, ph_hi; };
enum { I_X = 0, I_AWIN, I_ABIN, I_ALNG, I_ALNB, I_AWS, I_ABS, I_AWOUT, I_BWQKV, I_BBQKV, I_BSINK, I_BWO, I_BBO,
       I_MWR, I_MRB, I_MWG, I_MWU, I_MWD, I_SWG, I_SWU, I_SWD, I_NG, I_NB };

__device__ __forceinline__ float wave_sum(float v) {
#pragma unroll
    for (int o = 1; o < 64; o <<= 1) v += __shfl_xor(v, o);
    return v;
}

__device__ __forceinline__ void p0_transpose_item(const float* W, int N, bf16* WT, int Kd, int k0, int n0, int drow0, LAS float* scr, int lane) {
#pragma unroll 8
    for (int i = 0; i < 32; ++i) { const int kk = 2 * i + (lane >> 5); scr[kk * 33 + (lane & 31)] = W[(size_t)(k0 + kk) * N + n0 + (lane & 31)]; }
    LDS_WAIT(); asm volatile("" ::: "memory");
    const int c = lane & 7;
#pragma unroll
    for (int j = 0; j < 4; ++j) { const int n = (lane >> 3) + 8 * j; const LAS float* s = scr + (8 * c) * 33 + n;
        v4u o; o.x = pk2(s[0 * 33], s[1 * 33]); o.y = pk2(s[2 * 33], s[3 * 33]); o.z = pk2(s[4 * 33], s[5 * 33]); o.w = pk2(s[6 * 33], s[7 * 33]);
        *(GAS v4u*)(WT + (size_t)(drow0 + n) * Kd + k0 + 8 * c) = o; }
    LDS_WAIT(); asm volatile("" ::: "memory");
}
__device__ __forceinline__ void p0_prologue(Frame& F, const Args& AR) {
    LAS float* scr = (LAS float*)(F.lds + RING_OFF + F.wave * 16384);
    const int gw = F.vcu * NWAVES + F.wave, NGW = F.G * NWAVES;
    bf16* Win_t = (bf16*)(F.ws + WS_WIN); bf16* Wout_t = (bf16*)(F.ws + WS_WOUT); bf16* Wqkv_t = (bf16*)(F.ws + WS_WQKV); bf16* Wo_t = (bf16*)(F.ws + WS_WO);
    bf16* Wgu_t = (bf16*)(F.ws + WS_WGU); bf16* Wd_t = (bf16*)(F.ws + WS_WD);
    constexpr int J_WIN = 32 * 128, J_WOUT = 32 * 64, J_WQKV = 32 * 80, J_WO = 32 * 64;
    constexpr int J_GU = 32 * 16;
    constexpr int J_DN = 8 * 64;
    constexpr int N_MOE = 2 * NE;
    constexpr int B0 = 0, B1 = B0 + J_WIN, B2 = B1 + J_WOUT, B3 = B2 + J_WQKV, B4 = B3 + J_WO;
    constexpr int B5 = B4 + N_MOE * J_GU;
    constexpr int B6 = B5 + N_MOE * J_GU;
    constexpr int B7 = B6 + N_MOE * J_DN;
    constexpr int B8 = B7 + 2 * J_GU;
    constexpr int B9 = B8 + 2 * J_GU;
    constexpr int B10 = B9 + 2 * J_DN;
    for (int it = gw; it < B10; it += NGW) {
        if (it < B1) { const int r = it - B0, kb = r / 128, nb = r % 128; p0_transpose_item(AR.in[I_AWIN], 4096, Win_t, 2048, 64 * kb, 32 * nb, 32 * nb, scr, F.lane); }
        else if (it < B2) { const int r = it - B1, kb = r / 64, nb = r % 64; p0_transpose_item(AR.in[I_AWOUT], 2048, Wout_t, 2048, 64 * kb, 32 * nb, 32 * nb, scr, F.lane); }
        else if (it < B3) { const int r = it - B2, kb = r / 80, nb = r % 80; p0_transpose_item(AR.in[I_BWQKV], 2560, Wqkv_t, 2048, 64 * kb, 32 * nb, 32 * nb, scr, F.lane); }
        else if (it < B4) { const int r = it - B3, kb = r / 64, nb = r % 64; p0_transpose_item(AR.in[I_BWO], 2048, Wo_t, 2048, 64 * kb, 32 * nb, 32 * nb, scr, F.lane); }
        else if (it < B6) { const bool up = it >= B5; const int r = it - (up ? B5 : B4), mat = r / J_GU, q = r % J_GU, kb = q / 16, nb = q % 16, l = mat / NE, e = mat % NE;
            const float* src = AR.in[up ? I_MWU : I_MWG] + (size_t)mat * 2048 * 512; bf16* dst = Wgu_t + ((size_t)(l * NE1 + e)) * 1024 * 2048;
            const int n0 = 32 * nb, drow0 = (n0 >> 7) * 256 + (up ? 128 : 0) + (n0 & 127);
            p0_transpose_item(src, 512, dst, 2048, 64 * kb, n0, drow0, scr, F.lane); }
        else if (it < B7) { const int r = it - B6, mat = r / J_DN, q = r % J_DN, kb = q / 64, nb = q % 64, l = mat / NE, e = mat % NE;
            const float* src = AR.in[I_MWD] + (size_t)mat * 512 * 2048; bf16* dst = Wd_t + ((size_t)(l * NE1 + e)) * 2048 * 512;
            p0_transpose_item(src, 2048, dst, 512, 64 * kb, 32 * nb, 32 * nb, scr, F.lane); }
        else if (it < B9) { const bool up = it >= B8; const int r = it - (up ? B8 : B7), l = r / J_GU, q = r % J_GU, kb = q / 16, nb = q % 16;
            const float* src = AR.in[up ? I_SWU : I_SWG] + (size_t)l * 2048 * 512; bf16* dst = Wgu_t + ((size_t)(l * NE1 + NE)) * 1024 * 2048;
            const int n0 = 32 * nb, drow0 = (n0 >> 7) * 256 + (up ? 128 : 0) + (n0 & 127);
            p0_transpose_item(src, 512, dst, 2048, 64 * kb, n0, drow0, scr, F.lane); }
        else { const int r = it - B9, l = r / J_DN, q = r % J_DN, kb = q / 64, nb = q % 64;
            const float* src = AR.in[I_SWD] + (size_t)l * 512 * 2048; bf16* dst = Wd_t + ((size_t)(l * NE1 + NE)) * 2048 * 512;
            p0_transpose_item(src, 2048, dst, 512, 64 * kb, 32 * nb, 32 * nb, scr, F.lane); }
    }
    { const GAS f32x4* xs = (const GAS f32x4*)AR.in[I_X]; GAS v4u* xd = (GAS v4u*)(F.ws + WS_XA); const size_t n8 = (size_t)T * D / 8;
      for (size_t i = (size_t)gw * 64 + F.lane; i < n8; i += (size_t)NGW * 64) { const f32x4 a = xs[2 * i], b = xs[2 * i + 1]; v4u o; o.x = pk2(a.x, a.y); o.y = pk2(a.z, a.w); o.z = pk2(b.x, b.y); o.w = pk2(b.z, b.w); xd[i] = o; } }
    if (F.vcu < 2) {
        __syncthreads();
        const int l = F.vcu, e = F.tid & 63, dg = F.tid >> 6;
        const float* Wr = AR.in[I_MWR] + (size_t)l * 2048 * 64; const float* g0 = AR.in[I_NG] + (size_t)(l * 2 + 0) * 2048; const float* b0 = AR.in[I_NB] + (size_t)(l * 2 + 0) * 2048;
        float* Wrp = (float*)(F.ws + WS_RT) + (size_t)l * 2048 * 64; float* c1 = (float*)(F.ws + WS_RT + 1 * MiB) + l * 64; float* c0 = (float*)(F.ws + WS_RT + 1 * MiB) + 128 + l * 64;
        float s1 = 0.f, s0 = 0.f;
        for (int d = dg * 256; d < dg * 256 + 256; ++d) { const float w = Wr[(size_t)d * 64 + e]; const float wp = g0[d] * w; Wrp[(size_t)d * 64 + e] = wp; s1 += wp; s0 += b0[d] * w; }
        LAS float* red = (LAS float*)(F.lds + RING_OFF);
        __syncthreads();
        red[dg * 64 + e] = s1; red[512 + dg * 64 + e] = s0;
        __syncthreads();
        if (F.tid < 64) { float a = 0.f, b = 0.f;
#pragma unroll
            for (int k = 0; k < 8; ++k) { a += red[k * 64 + e]; b += red[512 + k * 64 + e]; }
            c1[e] = a; c0[e] = b; }
        __syncthreads();
    }
}

__device__ __forceinline__ void p2_sgu(Frame& F, const Args& AR) {
    LAS float* s_mu = (LAS float*)(F.lds + RING_OFF);
    LAS float* s_rs = (LAS float*)(F.lds + RING_OFF + 512);
    LAS bf16* vt = (LAS bf16*)(F.lds + RING_OFF + 1024);
    const bf16* VT = (const bf16*)(F.ws + WS_VT); const bf16* U = (const bf16*)(F.ws + WS_U); bf16* GT = (bf16*)(F.ws + WS_GT);
    const float* vstat = (const float*)(F.ws + WS_VST);
    const float* Wsp = AR.in[I_AWS]; const float* bsp = AR.in[I_ABS]; const float* lng = AR.in[I_ALNG]; const float* lnb = AR.in[I_ALNB];
    const int fr = F.lane & 15, fq = F.lane >> 4, w = F.wave;
    for (int item = F.vcu; item < 256; item += F.G) {
        const int chunk = item >> 1, gh = item & 1, tok0 = chunk * 128;
        __syncthreads();
        if (F.tid < 128) { float a = 0.f, b = 0.f;
#pragma unroll
            for (int P = 0; P < 16; ++P) { const f32x2 v = *(const f32x2*)(vstat + ((size_t)P * T + tok0 + F.tid) * 2); a += v.x; b += v.y; }
            const float mean = a * (1.0f / AH); const float var = b * (1.0f / AH) - mean * mean; s_mu[F.tid] = mean; s_rs[F.tid] = 1.0f / sqrtf(var + LN_EPS); }
        for (int gi = 0; gi < 8; ++gi) {
            const int g = gh * 8 + gi;
            __syncthreads();
#pragma unroll
            for (int k = 0; k < 4; ++k) { const int p = F.tid + 512 * k, c = p >> 4, sp = p & 15;
                *(LAS v4u*)(vt + c * 136 + sp * 8) = *(const GAS v4u*)(VT + (size_t)(g * 128 + c) * T + tok0 + sp * 8); }
            __syncthreads();
            const int t = 16 * w + fr;
            f32x4 acc[8];
#pragma unroll
            for (int cb = 0; cb < 8; ++cb) acc[cb] = (f32x4){0.f, 0.f, 0.f, 0.f};
            float c1 = 0.f, c2 = 0.f;
            const int nks = (16 * w + 15) / 32 + 1;
#pragma unroll
            for (int ks = 0; ks < 4; ++ks) { if (ks < nks) {
                const int s0 = 32 * ks + 8 * fq;
                const float* wp = Wsp + ((size_t)g * 128 + t) * 128 + s0;
                const f32x4 wa = *(const f32x4*)wp, wb = *(const f32x4*)(wp + 4);
                const f32x4 ra = *(const LAS f32x4*)(s_rs + s0), rb = *(const LAS f32x4*)(s_rs + s0 + 4);
                const f32x4 ma = *(const LAS f32x4*)(s_mu + s0), mb = *(const LAS f32x4*)(s_mu + s0 + 4);
                float wv[8], rv[8], mv[8], wq[8];
#pragma unroll
                for (int j = 0; j < 4; ++j) { wv[j] = wa[j]; wv[4 + j] = wb[j]; rv[j] = ra[j]; rv[4 + j] = rb[j]; mv[j] = ma[j]; mv[4 + j] = mb[j]; }
#pragma unroll
                for (int j = 0; j < 8; ++j) { const float w0 = (s0 + j <= t) ? wv[j] : 0.f; c2 += w0; wq[j] = w0 * rv[j]; c1 += wq[j] * mv[j]; }
                v4u yp; yp.x = pk2(wq[0], wq[1]); yp.y = pk2(wq[2], wq[3]); yp.z = pk2(wq[4], wq[5]); yp.w = pk2(wq[6], wq[7]);
                const bf16x8 Y = __builtin_bit_cast(bf16x8, yp);
#pragma unroll
                for (int cb = 0; cb < 8; ++cb) { const bf16x8 X = *(const LAS bf16x8*)(vt + (16 * cb + fr) * 136 + 32 * ks + 8 * fq);
                    acc[cb] = __builtin_amdgcn_mfma_f32_16x16x32_bf16(X, Y, acc[cb], 0, 0, 0); }
            } }
            c1 += __shfl_xor(c1, 16); c1 += __shfl_xor(c1, 32); c2 += __shfl_xor(c2, 16); c2 += __shfl_xor(c2, 32);
            const float bsv = bsp[g * 128 + t];
            const size_t rowoff = (size_t)(tok0 + t) * AH;
#pragma unroll
            for (int cb = 0; cb < 8; ++cb) { const int j0 = g * 128 + 16 * cb + 4 * fq;
                const f32x4 g4 = *(const f32x4*)(lng + j0), b4 = *(const f32x4*)(lnb + j0);
                const v2u uu = *(const GAS v2u*)(U + rowoff + j0);
                const float u0 = bflo(uu.x), u1 = bfhi(uu.x), u2 = bflo(uu.y), u3 = bfhi(uu.y);
                const float o0 = (g4[0] * (acc[cb][0] - c1) + b4[0] * c2 + bsv) * u0, o1 = (g4[1] * (acc[cb][1] - c1) + b4[1] * c2 + bsv) * u1;
                const float o2 = (g4[2] * (acc[cb][2] - c1) + b4[2] * c2 + bsv) * u2, o3 = (g4[3] * (acc[cb][3] - c1) + b4[3] * c2 + bsv) * u3;
                v2u o; o.x = pk2(o0, o1); o.y = pk2(o2, o3);
                *(GAS v2u*)(GT + rowoff + j0) = o; }
        }
    }
    __syncthreads();
}

__device__ __forceinline__ void attn_phase(Frame& F, const Args& AR) {
    LAS bf16* kt = (LAS bf16*)(F.lds + RING_OFF);
    LAS bf16* vtt = (LAS bf16*)(F.lds + RING_OFF + 36864);
    const bf16* QK = (const bf16*)(F.ws + WS_U); const bf16* VTA = (const bf16*)(F.ws + WS_VT); bf16* O = (bf16*)(F.ws + WS_GT);
    const float* sinks = AR.in[I_BSINK];
    const int fr = F.lane & 15, fq = F.lane >> 4, w = F.wave;
    const float LOG2E = 1.44269504089f;
    for (int unit = F.vcu; unit < 512; unit += F.G) {
        const int kvh = unit & 3, nbb = unit >> 2, nb = nbb & 15, tok0 = nbb * 128;
        __syncthreads();
#pragma unroll
        for (int k = 0; k < 4; ++k) { const int p = F.tid + 512 * k, key = p >> 3, pc = p & 7; const bool valid = (nb > 0) || key >= 128;
            v4u val = (v4u){0u, 0u, 0u, 0u}; if (valid) val = *(const GAS v4u*)(QK + (size_t)(tok0 - 128 + key) * QKW + 2048 + kvh * 64 + pc * 8);
            *(LAS v4u*)(kt + key * 72 + pc * 8) = val; }
#pragma unroll
        for (int k = 0; k < 4; ++k) { const int p = F.tid + 512 * k, d = p >> 5, pc = p & 31, key0 = pc * 8; const bool valid = (nb > 0) || key0 >= 128;
            v4u val = (v4u){0u, 0u, 0u, 0u}; if (valid) val = *(const GAS v4u*)(VTA + (size_t)(kvh * 64 + d) * T + tok0 - 128 + key0);
            *(LAS v4u*)(vtt + d * 264 + key0) = val; }
        __syncthreads();
        const int hq = kvh * 8 + w; const float slope = exp2f(-(float)(hq + 1) * 0.25f); const float sink = sinks[hq];
        for (int qc = 0; qc < 8; ++qc) {
            const int i = 16 * qc + fr; const size_t tokq = (size_t)(tok0 + i);
            const bf16x8 q0 = *(const GAS bf16x8*)(QK + tokq * QKW + hq * 64 + 8 * fq), q1 = *(const GAS bf16x8*)(QK + tokq * QKW + hq * 64 + 32 + 8 * fq);
            f32x4 s[9];
#pragma unroll
            for (int kk = 0; kk < 9; ++kk) { const int kb = qc + kk; s[kk] = (f32x4){0.f, 0.f, 0.f, 0.f};
                const bf16x8 X0 = *(const LAS bf16x8*)(kt + (16 * kb + fr) * 72 + 8 * fq), X1 = *(const LAS bf16x8*)(kt + (16 * kb + fr) * 72 + 32 + 8 * fq);
                s[kk] = __builtin_amdgcn_mfma_f32_16x16x32_bf16(X0, q0, s[kk], 0, 0, 0); s[kk] = __builtin_amdgcn_mfma_f32_16x16x32_bf16(X1, q1, s[kk], 0, 0, 0); }
            float mx = sink;
#pragma unroll
            for (int kk = 0; kk < 9; ++kk)
#pragma unroll
                for (int r = 0; r < 4; ++r) { const int jj = 16 * (qc + kk) + 4 * fq + r; const int dist = i + 128 - jj; const bool valid = (dist >= 0) && (dist < 128) && ((nb > 0) || (jj >= 128));
                    const float sc = valid ? (s[kk][r] - slope * (float)dist) : -INFINITY; s[kk][r] = sc; mx = fmaxf(mx, sc); }
            mx = fmaxf(mx, __shfl_xor(mx, 16)); mx = fmaxf(mx, __shfl_xor(mx, 32));
            float sum = 0.f;
#pragma unroll
            for (int kk = 0; kk < 9; ++kk)
#pragma unroll
                for (int r = 0; r < 4; ++r) { const float e = exp2f((s[kk][r] - mx) * LOG2E); s[kk][r] = e; sum += e; }
            sum += __shfl_xor(sum, 16); sum += __shfl_xor(sum, 32);
            sum += exp2f((sink - mx) * LOG2E);
            const float inv = 1.0f / sum;
            v2u pk[10];
#pragma unroll
            for (int kk = 0; kk < 9; ++kk) { pk[kk].x = pk2(s[kk][0] * inv, s[kk][1] * inv); pk[kk].y = pk2(s[kk][2] * inv, s[kk][3] * inv); }
            pk[9] = (v2u){0u, 0u};
            f32x4 o[4];
#pragma unroll
            for (int db = 0; db < 4; ++db) o[db] = (f32x4){0.f, 0.f, 0.f, 0.f};
#pragma unroll
            for (int st = 0; st < 5; ++st) { const int ka = 2 * st, kb2 = (2 * st + 1 < 9) ? 2 * st + 1 : 2 * st;
                v4u yp; yp.x = pk[2 * st].x; yp.y = pk[2 * st].y; yp.z = pk[2 * st + 1].x; yp.w = pk[2 * st + 1].y;
                const bf16x8 Y = __builtin_bit_cast(bf16x8, yp);
#pragma unroll
                for (int db = 0; db < 4; ++db) { const v2u xa = *(const LAS v2u*)(vtt + (16 * db + fr) * 264 + 16 * (qc + ka) + 4 * fq), xb = *(const LAS v2u*)(vtt + (16 * db + fr) * 264 + 16 * (qc + kb2) + 4 * fq);
                    v4u xp; xp.x = xa.x; xp.y = xa.y; xp.z = xb.x; xp.w = xb.y;
                    o[db] = __builtin_amdgcn_mfma_f32_16x16x32_bf16(__builtin_bit_cast(bf16x8, xp), Y, o[db], 0, 0, 0); } }
#pragma unroll
            for (int db = 0; db < 4; ++db) { v2u ov; ov.x = pk2(o[db][0], o[db][1]); ov.y = pk2(o[db][2], o[db][3]);
                *(GAS v2u*)(O + tokq * D + hq * 64 + 16 * db + 4 * fq) = ov; }
        }
    }
    __syncthreads();
}

__device__ __forceinline__ void moe_tables(Frame& F, int layer) {
    LAS int* tile_e = (LAS int*)(F.lds + TAB_TILE_E); LAS int* rts = (LAS int*)(F.lds + TAB_RTS); LAS int* cntl = (LAS int*)(F.lds + TAB_CNT); LAS int* pst = (LAS int*)(F.lds + TAB_PST);
    __syncthreads();
    if (F.tid < NE) { int c = (int)__hip_atomic_load((unsigned*)(F.ctl + CW_CNT + layer * 64 + F.tid), RLX_AGENT); if (c > CAP) c = CAP; cntl[F.tid] = c; }
    if (F.tid == NE) cntl[NE] = T;
    __syncthreads();
    if (F.tid == 0) { int acc = 0; for (int e = 0; e < NE1; ++e) { rts[e] = acc; pst[e] = acc * 256; acc += (cntl[e] + 255) >> 8; } rts[NE1] = acc; pst[NE1] = acc * 256; }
    __syncthreads();
    for (int e = F.tid >> 3; e < NE1; e += 64) { const int a = rts[e], b = rts[e + 1]; for (int rt = a + (F.tid & 7); rt < b; rt += 8) tile_e[rt] = e; }
    __syncthreads();
}
template <bool GATHER_> struct MoeOrder {
    static constexpr bool GATHER = GATHER_;
    pg8::StaticOrder so; LAS unsigned char* lds; int nNb;
    __device__ __forceinline__ void init(LAS unsigned char* lds_, int nN, int G, int c) { lds = lds_; nNb = nN; const int nrt = ((const LAS int*)(lds + TAB_RTS))[NE1]; so.init(nrt, nN, G, c); }
    __device__ __forceinline__ bool next(int i, pg8::Unit& u) const {
        if (i >= NU_MAX * (GATHER_ ? 1 : 4)) return false;
        if (!so.map(i, u.pm, u.pn)) return false;
        const int e = ((const LAS int*)(lds + TAB_TILE_E))[u.pm]; u.pb = e * nNb + u.pn; u.ord = i; return true; }
    __device__ __forceinline__ unsigned rowoff(int ord, int r) const { return ((const LAS unsigned*)(lds + ROWTAB_OFF))[ord * 256 + r]; }
    __device__ __forceinline__ void prepare(const int* slot_tok, const float* slot_w, int Kbytes, int tid) const {
        const LAS int* tile_e = (const LAS int*)(lds + TAB_TILE_E); const LAS int* rts = (const LAS int*)(lds + TAB_RTS); const LAS int* cntl = (const LAS int*)(lds + TAB_CNT);
        LAS unsigned* rowtab = (LAS unsigned*)(lds + ROWTAB_OFF); LAS float* roww = (LAS float*)(lds + ROWW_OFF);
        const int r = tid & 255;
        for (int i = tid >> 8; i < NU_MAX; i += 2) { int pm, pn; if (!so.map(i, pm, pn)) break;
            const int e = tile_e[pm]; const int pos = (pm - rts[e]) * 256 + r; int tok = 0; float w = 0.f;
            if (e == NE) { tok = pos; w = 1.f; } else if (pos < cntl[e]) { tok = slot_tok[(size_t)e * CAP + pos]; w = slot_w[(size_t)e * CAP + pos]; }
            rowtab[i * 256 + r] = (unsigned)tok * (unsigned)Kbytes; roww[i * 256 + r] = w; }
        __syncthreads();
    }
};

__device__ __forceinline__ void moe_route(Frame& F, const Args& AR, int layer) {
    LAS float* hc = (LAS float*)(F.lds + RING_OFF);
    LAS float* wrc = (LAS float*)(F.lds + RING_OFF + 33280);
    LAS float* lg = (LAS float*)(F.lds + RING_OFF + 74240);
    LAS unsigned* lcnt = (LAS unsigned*)(F.lds + RING_OFF + 90624);
    LAS unsigned* lbase = (LAS unsigned*)(F.lds + RING_OFF + 90880);
    LAS float* rst = (LAS float*)(F.lds + RING_OFF + 91136);
    LAS unsigned* tsel = (LAS unsigned*)(F.lds + RING_OFF + 91648);
    LAS float* tselw = (LAS float*)(F.lds + RING_OFF + 93696);
    const float* hbuf = (const float*)(F.ws + WS_HBUF); bf16* xa = (bf16*)(F.ws + WS_XA); float* stats1 = (float*)(F.ws + WS_ST1);
    const float* Wrp = (const float*)(F.ws + WS_RT) + (size_t)layer * 2048 * 64; const float* c1 = (const float*)(F.ws + WS_RT + 1 * MiB) + layer * 64; const float* c0 = (const float*)(F.ws + WS_RT + 1 * MiB) + 128 + layer * 64;
    const float* g0 = AR.in[I_NG] + (size_t)(layer * 2 + 0) * 2048; const float* b0 = AR.in[I_NB] + (size_t)(layer * 2 + 0) * 2048; const float* rbias = AR.in[I_MRB] + layer * 64;
    int* slot_tok = (int*)(F.ws + WS_STOK); float* slot_w = (float*)(F.ws + WS_SW); int* tok_slot = (int*)(F.ws + WS_TSLOT);
    unsigned* gcnt = (unsigned*)(F.ctl + CW_CNT + layer * 64);
    const int fr = F.lane & 15, fq = F.lane >> 4, w = F.wave;
    for (int blk = F.vcu; blk < T / 64; blk += F.G) {
        const int row0 = blk * 64;
        __syncthreads();
        if (F.tid < 64) lcnt[F.tid] = 0u;
        f32x4 racc[2]; racc[0] = (f32x4){0.f, 0.f, 0.f, 0.f}; racc[1] = (f32x4){0.f, 0.f, 0.f, 0.f};
        float ps = 0.f, pq = 0.f;
        const int lrow = F.tid >> 3, sub = F.tid & 7, rb = w >> 1, eb0 = (w & 1) * 2;
        for (int ch = 0; ch < 16; ++ch) {
            __syncthreads();
#pragma unroll
            for (int q = 0; q < 4; ++q) { const int c4 = sub + 8 * q; const f32x4 v = *(const GAS f32x4*)(hbuf + (size_t)(row0 + lrow) * D + ch * 128 + c4 * 4);
                ps += (v.x + v.y) + (v.z + v.w); pq += (v.x * v.x + v.y * v.y) + (v.z * v.z + v.w * v.w);
                LAS f32x2* dst = (LAS f32x2*)(hc + lrow * 130 + c4 * 4); dst[0] = (f32x2){v.x, v.y}; dst[1] = (f32x2){v.z, v.w}; }
#pragma unroll
            for (int q = 0; q < 4; ++q) { const int idx = F.tid + 512 * q, d = idx >> 4, e4 = idx & 15; *(LAS f32x4*)(wrc + d * 80 + e4 * 4) = *(const GAS f32x4*)(Wrp + (size_t)(ch * 128 + d) * 64 + e4 * 4); }
            __syncthreads();
#pragma unroll 8
            for (int ks = 0; ks < 32; ++ks) { const float a = hc[(rb * 16 + fr) * 130 + 4 * ks + fq];
                const float bA = wrc[(4 * ks + fq) * 80 + eb0 * 16 + fr], bB = wrc[(4 * ks + fq) * 80 + (eb0 + 1) * 16 + fr];
                racc[0] = __builtin_amdgcn_mfma_f32_16x16x4f32(a, bA, racc[0], 0, 0, 0); racc[1] = __builtin_amdgcn_mfma_f32_16x16x4f32(a, bB, racc[1], 0, 0, 0); }
        }
        ps += pg8::dppf<0xB1>(ps); ps += pg8::dppf<0x4E>(ps); ps += pg8::dppf<0x141>(ps);
        pq += pg8::dppf<0xB1>(pq); pq += pg8::dppf<0x4E>(pq); pq += pg8::dppf<0x141>(pq);
        if (sub == 0) { const float mean = ps * (1.0f / D); const float var = pq * (1.0f / D) - mean * mean; const float rstd = 1.0f / sqrtf(var + LN_EPS);
            rst[lrow * 2] = mean; rst[lrow * 2 + 1] = rstd; *(GAS f32x2*)(stats1 + (size_t)(row0 + lrow) * 2) = (f32x2){mean, rstd}; }
        __syncthreads();
#pragma unroll
        for (int n = 0; n < 2; ++n) { const int e = (eb0 + n) * 16 + fr; const float c1e = c1[e], c0e = c0[e];
#pragma unroll
            for (int r = 0; r < 4; ++r) { const int row = rb * 16 + 4 * fq + r; lg[row * 64 + e] = rst[row * 2 + 1] * (racc[n][r] - rst[row * 2] * c1e) + c0e; } }
        __syncthreads();
        for (int rr = 0; rr < 8; ++rr) {
            const int row = 8 * w + rr; const float mean = rst[row * 2], rstd = rst[row * 2 + 1];
            const size_t ro = (size_t)(row0 + row) * D;
#pragma unroll
            for (int j = 0; j < 4; ++j) { const int c = 512 * j + 8 * F.lane;
                const f32x4 ha = *(const GAS f32x4*)(hbuf + ro + c), hb = *(const GAS f32x4*)(hbuf + ro + c + 4);
                const f32x4 ga = *(const f32x4*)(g0 + c), gb = *(const f32x4*)(g0 + c + 4), ba = *(const f32x4*)(b0 + c), bb = *(const f32x4*)(b0 + c + 4);
                const f32x4 xa4 = (ha - mean) * rstd * ga + ba, xb4 = (hb - mean) * rstd * gb + bb;
                v4u o; o.x = pk2(xa4.x, xa4.y); o.y = pk2(xa4.z, xa4.w); o.z = pk2(xb4.x, xb4.y); o.w = pk2(xb4.z, xb4.w);
                *(GAS v4u*)(xa + ro + c) = o; }
            const float logit = lg[row * 64 + F.lane];
            const float score = 1.0f / (1.0f + __expf(-logit));
            const float sel = score + rbias[F.lane];
            float m1 = sel; m1 = fmaxf(m1, pg8::dppf<0xB1>(m1)); m1 = fmaxf(m1, pg8::dppf<0x4E>(m1)); m1 = fmaxf(m1, pg8::dppf<0x141>(m1));
            const unsigned long long eq = __ballot(sel == m1); const int gsh = F.lane & ~7; const unsigned gm = (unsigned)((eq >> gsh) & 0xffull);
            const int first = gsh + __builtin_ctz(gm | 0x100u);
            float m2 = (F.lane == first) ? -INFINITY : sel; m2 = fmaxf(m2, pg8::dppf<0xB1>(m2)); m2 = fmaxf(m2, pg8::dppf<0x4E>(m2)); m2 = fmaxf(m2, pg8::dppf<0x141>(m2));
            const float gs = m1 + m2; const int g = F.lane >> 3; int grank = 0;
#pragma unroll
            for (int gg = 0; gg < 8; ++gg) { const float s = __builtin_bit_cast(float, __builtin_amdgcn_readlane(__builtin_bit_cast(int, gs), gg * 8)); grank += ((s > gs) || (s == gs && gg < g)) ? 1 : 0; }
            const float mv = (grank < 4) ? sel : -INFINITY; int rk = 0;
#pragma unroll 16
            for (int l = 0; l < 64; ++l) { const float s = __builtin_bit_cast(float, __builtin_amdgcn_readlane(__builtin_bit_cast(int, mv), l)); rk += ((s > mv) || (s == mv && l < F.lane)) ? 1 : 0; }
            const bool chosen = rk < 8;
            float wt = chosen ? score : 0.f; const float wsum = wave_sum(wt); wt = wt / (wsum + 1e-20f) * 2.5f;
            const unsigned long long cm = __ballot(chosen);
            if (chosen) { const int k = __builtin_popcountll(cm & ((1ull << F.lane) - 1ull)); const unsigned lr = __hip_atomic_fetch_add(&lcnt[F.lane], 1u, __ATOMIC_RELAXED, __HIP_MEMORY_SCOPE_WORKGROUP);
                if (k < 8) { tsel[row * 8 + k] = ((unsigned)F.lane << 16) | lr; tselw[row * 8 + k] = wt; } }
        }
        __syncthreads();
        if (F.tid < 64) lbase[F.tid] = __hip_atomic_fetch_add(gcnt + F.tid, lcnt[F.tid], RLX_AGENT);
        __syncthreads();
        { const int row = F.tid >> 3, k = F.tid & 7; const unsigned v = tsel[row * 8 + k]; const int e = (int)(v >> 16); const unsigned pos = lbase[e] + (v & 0xffffu);
          const int tok = row0 + row;
          if (pos < (unsigned)CAP) { slot_tok[(size_t)e * CAP + pos] = tok; slot_w[(size_t)e * CAP + pos] = tselw[row * 8 + k]; }
          tok_slot[(size_t)tok * 8 + k] = e * CAP + (int)(pos < (unsigned)CAP ? pos : CAP - 1); }
    }
    __syncthreads();
}

__device__ __forceinline__ void moe_combine(Frame& F, const Args& AR, int layer) {
    float* hbuf = (float*)(F.ws + WS_HBUF); bf16* xa = (bf16*)(F.ws + WS_XA); const float* stats1 = (const float*)(F.ws + WS_ST1);
    const bf16* Y = (const bf16*)(F.ws + WS_Y); const int* tok_slot = (const int*)(F.ws + WS_TSLOT);
    const float* g0 = AR.in[I_NG] + (size_t)(layer * 2 + 0) * 2048; const float* b0 = AR.in[I_NB] + (size_t)(layer * 2 + 0) * 2048;
    const float* g1 = AR.in[I_NG] + (size_t)(layer * 2 + 1) * 2048; const float* b1 = AR.in[I_NB] + (size_t)(layer * 2 + 1) * 2048;
    const LAS int* pst = (const LAS int*)(F.lds + TAB_PST);
    const int gw = F.vcu * NWAVES + F.wave, NGW = F.G * NWAVES;
    for (int tok = gw; tok < T; tok += NGW) {
        int myrow = 0;
        if (F.lane < 8) { const int ts = tok_slot[(size_t)tok * 8 + F.lane]; myrow = pst[ts >> 14] + (ts & (CAP - 1)); }
        if (F.lane == 8) myrow = pst[NE] + tok;
        int rows[9];
#pragma unroll
        for (int k = 0; k < 9; ++k) rows[k] = __builtin_amdgcn_readlane(myrow, k);
        const f32x2 st = *(const GAS f32x2*)(stats1 + (size_t)tok * 2);
        const size_t ro = (size_t)tok * D;
        f32x4 z[4][2]; float s = 0.f;
#pragma unroll
        for (int j = 0; j < 4; ++j) { const int c = 512 * j + 8 * F.lane;
            const f32x4 ha = *(const GAS f32x4*)(hbuf + ro + c), hb = *(const GAS f32x4*)(hbuf + ro + c + 4);
            const f32x4 ga = *(const f32x4*)(g0 + c), gb = *(const f32x4*)(g0 + c + 4), ba = *(const f32x4*)(b0 + c), bb = *(const f32x4*)(b0 + c + 4);
            f32x4 za = ((ha - st.x) * st.y * ga + ba) * DN_ALPHA, zb = ((hb - st.x) * st.y * gb + bb) * DN_ALPHA;
#pragma unroll
            for (int k = 0; k < 9; ++k) { const v4u y = *(const GAS v4u*)(Y + (size_t)rows[k] * D + c);
                za += (f32x4){bflo(y.x), bfhi(y.x), bflo(y.y), bfhi(y.y)}; zb += (f32x4){bflo(y.z), bfhi(y.z), bflo(y.w), bfhi(y.w)}; }
            z[j][0] = za; z[j][1] = zb; s += (za.x + za.y) + (za.z + za.w) + (zb.x + zb.y) + (zb.z + zb.w); }
        const float mean = wave_sum(s) * (1.0f / D); float q = 0.f;
#pragma unroll
        for (int j = 0; j < 4; ++j)
#pragma unroll
            for (int h = 0; h < 2; ++h) { z[j][h] = z[j][h] - mean; q += (z[j][h].x * z[j][h].x + z[j][h].y * z[j][h].y) + (z[j][h].z * z[j][h].z + z[j][h].w * z[j][h].w); }
        const float rstd = 1.0f / sqrtf(wave_sum(q) * (1.0f / D) + LN_EPS);
        float* dst = (layer == 0) ? hbuf : AR.out;
#pragma unroll
        for (int j = 0; j < 4; ++j) { const int c = 512 * j + 8 * F.lane;
            const f32x4 ga = *(const f32x4*)(g1 + c), gb = *(const f32x4*)(g1 + c + 4), ba = *(const f32x4*)(b1 + c), bb = *(const f32x4*)(b1 + c + 4);
            const f32x4 oa = z[j][0] * rstd * ga + ba, ob = z[j][1] * rstd * gb + bb;
            *(GAS f32x4*)(dst + ro + c) = oa; *(GAS f32x4*)(dst + ro + c + 4) = ob;
            if (layer == 0) { v4u o; o.x = pk2(oa.x, oa.y); o.y = pk2(oa.z, oa.w); o.z = pk2(ob.x, ob.y); o.w = pk2(ob.z, ob.w); *(GAS v4u*)(xa + ro + c) = o; } }
    }
}

#define IN(k) (lo <= (k) && (k) < hi)
#define SEAM(k) do { if (IN(k) && IN((k) + 1)) xcd_barrier(bar); } while (0)
template <int LAYER>
__device__ __forceinline__ void moe_block(Frame& F, const Args& args, const XcdBarrier& bar, const int lo, const int hi) {
    constexpr int pb = 1 + 7 * LAYER;
    LAS unsigned char* ring = F.lds + RING_OFF;
    const int cidx = (int)blockIdx.x;
    if (EN(7) && IN(pb + 3)) { moe_route(F, args, LAYER); } SEAM(pb + 3);
    if (EN(8) && IN(pb + 4)) {
        moe_tables(F, LAYER);
        MoeOrder<true> S; S.init(F.lds, 4, F.G, cidx);
        S.prepare((const int*)(F.ws + WS_STOK), (const float*)(F.ws + WS_SW), D * 2, F.tid);
        pg8::Gemm g{(const bf16*)(F.ws + WS_XA), (const bf16*)(F.ws + WS_WGU) + (size_t)LAYER * NE1 * 1024 * 2048, D};
        pg8::EpiSwiGLU E{(bf16*)(F.ws + WS_H), EFF, ROWW_OFF};
        pg8::gemm_phase<pg8::EpiSwiGLU, MoeOrder<true>>(ring, F.lds, g, S, E);
    } SEAM(pb + 4);
    if (EN(9) && IN(pb + 5)) {
        moe_tables(F, LAYER);
        MoeOrder<false> S; S.init(F.lds, 8, F.G, cidx);
        pg8::Gemm g{(const bf16*)(F.ws + WS_H), (const bf16*)(F.ws + WS_WD) + (size_t)LAYER * NE1 * 2048 * 512, EFF};
        pg8::EpiBf16<0> E{(bf16*)(F.ws + WS_Y), D, nullptr, 0, 1.f};
        pg8::gemm_phase<pg8::EpiBf16<0>, MoeOrder<false>>(ring, F.lds, g, S, E);
    } SEAM(pb + 5);
    if (EN(10) && IN(pb + 6)) { moe_tables(F, LAYER); moe_combine(F, args, LAYER); }
    if (LAYER == 0) SEAM(pb + 6);
}

__global__ void __launch_bounds__(NWAVES * 64, 2) fwd(Args args) {
    extern __shared__ __attribute__((aligned(16))) unsigned char lds[];
    Frame F;
    F.lds = (LAS unsigned char*)lds;
    F.MISC = (volatile LAS unsigned*)(F.lds + MISC_OFF);
    F.tid = threadIdx.x; F.lane = F.tid & 63; F.wave = __builtin_amdgcn_readfirstlane(F.tid >> 6);
    F.G = gridDim.x; { const int bx = blockIdx.x; F.vcu = (F.G % 8 == 0) ? (bx % 8) * (F.G / 8) + bx / 8 : bx; }
    F.ws = args.ws; F.ctl = (gu32*)(args.ws + WS_CTL);
    const Args& AR = args;
    if (F.tid < 64) F.MISC[F.tid] = 0u;
    __syncthreads();
    const int lo = args.ph_lo, hi = args.ph_hi;
    XcdBarrier bar; bar.bar = (unsigned*)(F.ctl + CW_BAR); bar.x = 0; bar.st = nullptr;
    if (hi - lo > 1) bar = xcd_barrier_post((unsigned*)(F.ctl + CW_BAR), F.MISC + 8);
    LAS unsigned char* ring = F.lds + RING_OFF;
    const int cidx = (int)blockIdx.x;

    if (EN(0) && IN(0)) { p0_prologue(F, args); } SEAM(0);

    if (EN(1) && IN(1)) {
        { pg8::Gemm g{(const bf16*)(F.ws + WS_XA), (const bf16*)(F.ws + WS_WIN), D}; pg8::StaticOrder S; S.init(T / 256, AH / 256, F.G, cidx);
          pg8::EpiBf16<1> E{(bf16*)(F.ws + WS_U), AH, AR.in[I_ABIN], 0, 1.f};
          pg8::gemm_phase<pg8::EpiBf16<1>, pg8::StaticOrder>(ring, F.lds, g, S, E); }
        { pg8::Gemm g{(const bf16*)(F.ws + WS_WIN) + (size_t)AH * D, (const bf16*)(F.ws + WS_XA), D}; pg8::StaticOrder S; S.init(AH / 256, T / 256, F.G, cidx);
          pg8::EpiRowBias<true, true> E{(bf16*)(F.ws + WS_VT), T, AR.in[I_ABIN] + AH, (float*)(F.ws + WS_VST), T};
          pg8::gemm_phase<pg8::EpiRowBias<true, true>, pg8::StaticOrder>(ring, F.lds, g, S, E); }
    } SEAM(1);
    if (EN(2) && IN(2)) { p2_sgu(F, args); } SEAM(2);
    if (EN(3) && IN(3)) {
        pg8::Gemm g{(const bf16*)(F.ws + WS_GT), (const bf16*)(F.ws + WS_WOUT), AH}; pg8::StaticOrder S; S.init(T / 256, D / 256, F.G, cidx);
        pg8::EpiResF32 E{AR.in[I_X], (float*)(F.ws + WS_HBUF), D, nullptr, DN_ALPHA};
        pg8::gemm_phase<pg8::EpiResF32, pg8::StaticOrder>(ring, F.lds, g, S, E);
    } SEAM(3);
    moe_block<0>(F, args, bar, lo, hi);

    if (EN(4) && IN(8)) {
        { pg8::Gemm g{(const bf16*)(F.ws + WS_XA), (const bf16*)(F.ws + WS_WQKV), D}; pg8::StaticOrder S; S.init(T / 256, QKW / 256, F.G, cidx);
          pg8::EpiBf16<0> E{(bf16*)(F.ws + WS_U), QKW, AR.in[I_BBQKV], 8, 0.125f};
          pg8::gemm_phase<pg8::EpiBf16<0>, pg8::StaticOrder>(ring, F.lds, g, S, E); }
        { pg8::Gemm g{(const bf16*)(F.ws + WS_WQKV) + (size_t)QKW * D, (const bf16*)(F.ws + WS_XA), D}; pg8::StaticOrder S; S.init(1, T / 256, F.G, (cidx + F.G - 64) % F.G);
          pg8::EpiRowBias<false, false> E{(bf16*)(F.ws + WS_VT), T, AR.in[I_BBQKV] + QKW, nullptr, T};
          pg8::gemm_phase<pg8::EpiRowBias<false, false>, pg8::StaticOrder>(ring, F.lds, g, S, E); }
    } SEAM(8);
    if (EN(5) && IN(9)) { attn_phase(F, args); } SEAM(9);
    if (EN(6) && IN(10)) {
        pg8::Gemm g{(const bf16*)(F.ws + WS_GT), (const bf16*)(F.ws + WS_WO), D}; pg8::StaticOrder S; S.init(T / 256, D / 256, F.G, cidx);
        pg8::EpiResF32 E{(const float*)(F.ws + WS_HBUF), (float*)(F.ws + WS_HBUF), D, AR.in[I_BBO], DN_ALPHA};
        pg8::gemm_phase<pg8::EpiResF32, pg8::StaticOrder>(ring, F.lds, g, S, E);
    } SEAM(10);
    moe_block<1>(F, args, bar, lo, hi);
}
#undef IN
#undef SEAM

extern "C" void kernel_launch(void* const* d_in, const int* in_sizes, int n_in, void* d_out, int out_size, void* d_ws, size_t ws_size, hipStream_t stream) {
    static int grid = 0;
    if (grid == 0) {
        if (n_in != 23 || out_size != T * D || ws_size < WS_END) { fprintf(stderr, "kernel_launch: unexpected problem (n_in %d out %d ws %zu, need %zu)\n", n_in, out_size, ws_size, (size_t)WS_END); grid = -1; return; }
        int dev = 0, cus = 0, per_cu = 0;
        if (hipGetDevice(&dev) != hipSuccess || hipDeviceGetAttribute(&cus, hipDeviceAttributeMultiprocessorCount, dev) != hipSuccess) { grid = -1; return; }
        if (hipFuncSetAttribute((const void*)fwd, hipFuncAttributeMaxDynamicSharedMemorySize, LDS_BYTES) != hipSuccess) { fprintf(stderr, "kernel_launch: hipFuncSetAttribute failed\n"); grid = -1; return; }
        if (hipOccupancyMaxActiveBlocksPerMultiprocessor(&per_cu, (const void*)fwd, NWAVES * 64, LDS_BYTES) != hipSuccess || per_cu < 1)
            fprintf(stderr, "kernel_launch: occupancy query reports %d workgroups per CU\n", per_cu);
        (void)hipGetLastError();
        grid = cus;
    }
    if (grid < 0) return;
    if (hipMemsetAsync((char*)d_ws + WS_CTL, 0, CTL_ZERO_BYTES, stream) != hipSuccess) { fprintf(stderr, "kernel_launch: memset failed\n"); return; }
    Args a{};
    for (int i = 0; i < 23; ++i) a.in[i] = (const float*)d_in[i];
    a.out = (float*)d_out; a.ws = (unsigned char*)d_ws;
    constexpr int NL = MK_N_LAUNCHES;
    for (int li = 0; li < NL; ++li) {
        a.ph_lo = (NL == 1) ? 0 : li; a.ph_hi = (NL == 1) ? N_PHASES : li + 1;
        hipLaunchKernelGGL(fwd, dim3(grid), dim3(NWAVES * 64), LDS_BYTES, stream, a);
        const hipError_t le = hipPeekAtLastError();
        if (le != hipSuccess) { fprintf(stderr, "kernel_launch: launch %d failed: %s\n", li, hipGetErrorName(le)); break; }
    }
}
```
